# Optimizing an MI355X kernel written in HIP

```python
import math
import jax
import jax.numpy as jnp
from jax import lax
import numpy as np

D_MODEL = 1024
BATCH = 8
SEQ = 4096
DEPTH = 4

FOX_HEADS = 8
FOX_HEAD_DIM = D_MODEL // 16
FOX_WIDTH = FOX_HEADS * FOX_HEAD_DIM
FOX_Q_BLOCK = 128
POOL_WINDOWS = (2, 4, 8, 16)
POOL_GROUPS = len(POOL_WINDOWS)
POOL_WIDTH = D_MODEL // 2
POOL_GROUP_DIM = POOL_WIDTH // POOL_GROUPS
EVEN_IN = 3 * FOX_WIDTH + FOX_HEADS + POOL_WIDTH
MOBA_HEADS = 16
MOBA_HEAD_DIM = D_MODEL // MOBA_HEADS
MOBA_WIDTH = MOBA_HEADS * MOBA_HEAD_DIM
MOBA_BLOCK = 256
MOBA_TOPK = 3
MOBA_Q_CHUNK = 16
D_FF = D_MODEL * 7 // 2
N_EXPERTS = 8
TOP_K = 2
LN_EPS = 1e-5
DEEPNORM_ALPHA = (2 * DEPTH) ** 0.25
DEEPNORM_BETA = (8 * DEPTH) ** -0.25
N_EVEN = (DEPTH + 1) // 2
N_ODD = DEPTH // 2

kernel_name = 'fox_pool_moba_moe_deepnorm_trunk'


def layer_norm(x, g, b):
    xf = x.astype(jnp.float32)
    mu = xf.mean(-1, keepdims=True)
    var = jnp.square(xf - mu).mean(-1, keepdims=True)
    return ((xf - mu) * lax.rsqrt(var + LN_EPS) * g + b).astype(x.dtype)


def split_heads(t, n_heads):
    b, s, _ = t.shape
    return t.reshape(b, s, n_heads, -1).transpose(0, 2, 1, 3)


def merge_heads(t):
    b, h, s, d = t.shape
    return t.transpose(0, 2, 1, 3).reshape(b, s, h * d)


def fox_attention(q, k, v, logf):
    b, h, s, d = q.shape
    nq = s // FOX_Q_BLOCK
    scale = d ** -0.5
    cum = jnp.cumsum(logf, axis=-1)
    qb = q.reshape(b, h, nq, FOX_Q_BLOCK, d).transpose(2, 0, 1, 3, 4)
    cb = cum.reshape(b, h, nq, FOX_Q_BLOCK).transpose(2, 0, 1, 3)
    kpos = jnp.arange(s)

    def block(args):
        q_blk, c_blk, i = args
        logits = jnp.einsum('bhqd,bhkd->bhqk', q_blk, k).astype(jnp.float32) * scale
        logits = logits + c_blk[..., None] - cum[:, :, None, :]
        qpos = i * FOX_Q_BLOCK + jnp.arange(FOX_Q_BLOCK)
        logits = jnp.where(kpos[None, :] <= qpos[:, None], logits, -jnp.inf)
        p = jax.nn.softmax(logits, axis=-1)
        return jnp.einsum('bhqk,bhkd->bhqd', p.astype(v.dtype), v)

    out = lax.map(block, (qb, cb, jnp.arange(nq)))
    return out.transpose(1, 2, 0, 3, 4).reshape(b, h, s, d)


def multiscale_pool(u, pool_w, pool_scale):
    b, s, _ = u.shape
    ug = u.reshape(b, s, POOL_GROUPS, POOL_GROUP_DIM).astype(jnp.float32)
    csum = jnp.cumsum(ug, axis=1)
    t = jnp.arange(s)
    pooled = []
    for g, w in enumerate(POOL_WINDOWS):
        cpad = jnp.pad(csum[:, :, g], ((0, 0), (w, 0), (0, 0)))
        wsum = cpad[:, w:] - cpad[:, :s]
        cnt = jnp.minimum(t + 1, w).astype(jnp.float32)
        pooled.append(wsum / cnt[None, :, None])
    mixed = (jnp.stack(pooled, axis=2) - ug).astype(u.dtype)
    y = jnp.einsum('bsgc,gcd->bsgd', mixed, pool_w)
    return y.reshape(b, s, POOL_WIDTH) * pool_scale


def moba_attention(q, k, v):
    b, h, s, d = q.shape
    scale = d ** -0.5
    nb = -(-s // MOBA_BLOCK)
    pad = nb * MOBA_BLOCK - s
    kp = jnp.pad(k, ((0, 0), (0, 0), (0, pad), (0, 0)))
    vp = jnp.pad(v, ((0, 0), (0, 0), (0, pad), (0, 0)))
    kb = kp.reshape(b, h, nb, MOBA_BLOCK, d)
    vb = vp.reshape(b, h, nb, MOBA_BLOCK, d)
    kmean = kb.astype(jnp.float32).mean(axis=3)
    gate = jnp.einsum('bhsd,bhnd->bhsn', q.astype(jnp.float32), kmean)
    qblk = jnp.arange(s) // MOBA_BLOCK
    past = jnp.arange(nb)[None, :] < qblk[:, None]
    gate = jnp.where(past, gate, -jnp.inf)
    n_sel = min(MOBA_TOPK, nb)
    _, sel = lax.top_k(gate, n_sel)
    nc = s // MOBA_Q_CHUNK
    qc = q.reshape(b, h, nc, MOBA_Q_CHUNK, d).transpose(2, 0, 1, 3, 4)
    selc = sel.reshape(b, h, nc, MOBA_Q_CHUNK, n_sel).transpose(2, 0, 1, 3, 4)
    b_i = jnp.arange(b)[:, None, None, None]
    h_i = jnp.arange(h)[None, :, None, None]

    def chunk(args):
        q_c, sel_c, i = args
        start = i * MOBA_Q_CHUNK
        blk = start // MOBA_BLOCK
        k_sel = kb[b_i, h_i, sel_c]
        v_sel = vb[b_i, h_i, sel_c]
        s_sel = jnp.einsum('bhqd,bhqnkd->bhqnk', q_c, k_sel).astype(jnp.float32) * scale
        s_sel = jnp.where((sel_c < blk)[..., None], s_sel, -jnp.inf)
        s_sel = s_sel.reshape(b, h, MOBA_Q_CHUNK, n_sel * MOBA_BLOCK)
        k_own = lax.dynamic_slice_in_dim(kp, blk * MOBA_BLOCK, MOBA_BLOCK, axis=2)
        v_own = lax.dynamic_slice_in_dim(vp, blk * MOBA_BLOCK, MOBA_BLOCK, axis=2)
        s_own = jnp.einsum('bhqd,bhkd->bhqk', q_c, k_own).astype(jnp.float32) * scale
        kpos = blk * MOBA_BLOCK + jnp.arange(MOBA_BLOCK)
        qpos = start + jnp.arange(MOBA_Q_CHUNK)
        s_own = jnp.where(kpos[None, :] <= qpos[:, None], s_own, -jnp.inf)
        p = jax.nn.softmax(jnp.concatenate([s_sel, s_own], axis=-1), axis=-1).astype(v.dtype)
        p_sel = p[..., :n_sel * MOBA_BLOCK].reshape(b, h, MOBA_Q_CHUNK, n_sel, MOBA_BLOCK)
        p_own = p[..., n_sel * MOBA_BLOCK:]
        return (jnp.einsum('bhqnk,bhqnkd->bhqd', p_sel, v_sel)
                + jnp.einsum('bhqk,bhkd->bhqd', p_own, v_own))

    out = lax.map(chunk, (qc, selc, jnp.arange(nc)))
    return out.transpose(1, 2, 0, 3, 4).reshape(b, h, s, d)


def even_mixer(x, w_in, b_forget, pool_w, pool_scale, w_out):
    hcat = jnp.einsum('bsd,de->bse', x, w_in)
    q, k, v, f, u = jnp.split(hcat, [FOX_WIDTH, 2 * FOX_WIDTH, 3 * FOX_WIDTH, 3 * FOX_WIDTH + FOX_HEADS], axis=-1)
    logf = jax.nn.log_sigmoid((f + b_forget).astype(jnp.float32)).transpose(0, 2, 1)
    a = merge_heads(fox_attention(split_heads(q, FOX_HEADS), split_heads(k, FOX_HEADS),
                                  split_heads(v, FOX_HEADS), logf))
    p = multiscale_pool(u, pool_w, pool_scale)
    return jnp.einsum('bse,ed->bsd', jnp.concatenate([a, p], axis=-1), w_out)


def odd_mixer(x, w_in, w_out):
    hcat = jnp.einsum('bsd,de->bse', x, w_in)
    q, k, v = jnp.split(hcat, 3, axis=-1)
    o = moba_attention(split_heads(q, MOBA_HEADS), split_heads(k, MOBA_HEADS), split_heads(v, MOBA_HEADS))
    return jnp.einsum('bse,ed->bsd', merge_heads(o), w_out)


def swiglu(x, w_gate, w_up, w_down):
    hid = jax.nn.silu(jnp.einsum('bsd,df->bsf', x, w_gate)) * jnp.einsum('bsd,df->bsf', x, w_up)
    return jnp.einsum('bsf,fd->bsd', hid, w_down)


def moe_ffn(x, w_router, w_gate, w_up, w_down):
    logits = jnp.einsum('bsd,de->bse', x, w_router).astype(jnp.float32)
    vals, idx = lax.top_k(logits, TOP_K)
    gates = jax.nn.softmax(vals, axis=-1)
    combine = jnp.sum(gates[..., None] * jax.nn.one_hot(idx, N_EXPERTS, dtype=jnp.float32), axis=-2)
    y = jnp.zeros_like(x)
    for e in range(N_EXPERTS):
        y = y + combine[..., e:e + 1].astype(x.dtype) * swiglu(x, w_gate[e], w_up[e], w_down[e])
    return y


def setup_inputs(seed: int = 0) -> dict:
    key = jax.random.key(seed)
    ks = jax.random.split(key, 20)
    nrm = jax.random.normal
    f32 = jnp.float32
    sd = D_MODEL ** -0.5
    sf = D_FF ** -0.5
    return {
        'x': nrm(ks[0], (BATCH, SEQ, D_MODEL), f32),
        'ln1_g': 1.0 + 0.02 * nrm(ks[1], (DEPTH, D_MODEL), f32),
        'ln1_b': 0.02 * nrm(ks[2], (DEPTH, D_MODEL), f32),
        'ln2_g': 1.0 + 0.02 * nrm(ks[3], (DEPTH, D_MODEL), f32),
        'ln2_b': 0.02 * nrm(ks[4], (DEPTH, D_MODEL), f32),
        'ev_w_in': sd * nrm(ks[5], (N_EVEN, D_MODEL, EVEN_IN), f32),
        'ev_b_forget': jnp.linspace(1.0, 4.0, FOX_HEADS, dtype=f32)[None, :] + 0.1 * nrm(ks[6], (N_EVEN, FOX_HEADS), f32),
        'ev_pool_w': POOL_GROUP_DIM ** -0.5 * nrm(ks[7], (N_EVEN, POOL_GROUPS, POOL_GROUP_DIM, POOL_GROUP_DIM), f32),
        'ev_pool_scale': 1.0 + 0.1 * nrm(ks[8], (N_EVEN, POOL_WIDTH), f32),
        'ev_w_out': DEEPNORM_BETA * sd * nrm(ks[9], (N_EVEN, FOX_WIDTH + POOL_WIDTH, D_MODEL), f32),
        'ev_ffn_gate': sd * nrm(ks[10], (N_EVEN, D_MODEL, D_FF), f32),
        'ev_ffn_up': sd * nrm(ks[11], (N_EVEN, D_MODEL, D_FF), f32),
        'ev_ffn_down': DEEPNORM_BETA * sf * nrm(ks[12], (N_EVEN, D_FF, D_MODEL), f32),
        'od_w_in': sd * nrm(ks[13], (N_ODD, D_MODEL, 3 * MOBA_WIDTH), f32),
        'od_w_out': DEEPNORM_BETA * MOBA_WIDTH ** -0.5 * nrm(ks[14], (N_ODD, MOBA_WIDTH, D_MODEL), f32),
        'od_router': sd * nrm(ks[15], (N_ODD, D_MODEL, N_EXPERTS), f32),
        'od_exp_gate': sd * nrm(ks[16], (N_ODD, N_EXPERTS, D_MODEL, D_FF), f32),
        'od_exp_up': sd * nrm(ks[17], (N_ODD, N_EXPERTS, D_MODEL, D_FF), f32),
        'od_exp_down': DEEPNORM_BETA * sf * nrm(ks[18], (N_ODD, N_EXPERTS, D_FF, D_MODEL), f32),
    }


def reference(x, ln1_g, ln1_b, ln2_g, ln2_b, ev_w_in, ev_b_forget, ev_pool_w, ev_pool_scale, ev_w_out,
              ev_ffn_gate, ev_ffn_up, ev_ffn_down, od_w_in, od_w_out, od_router, od_exp_gate, od_exp_up,
              od_exp_down):
    for layer in range(DEPTH):
        i = layer // 2
        if layer % 2 == 0:
            mix = even_mixer(x, ev_w_in[i], ev_b_forget[i], ev_pool_w[i], ev_pool_scale[i], ev_w_out[i])
        else:
            mix = odd_mixer(x, od_w_in[i], od_w_out[i])
        x = layer_norm(DEEPNORM_ALPHA * x + mix, ln1_g[layer], ln1_b[layer])
        if layer % 2 == 0:
            ffn = swiglu(x, ev_ffn_gate[i], ev_ffn_up[i], ev_ffn_down[i])
        else:
            ffn = moe_ffn(x, od_router[i], od_exp_gate[i], od_exp_up[i], od_exp_down[i])
        x = layer_norm(DEEPNORM_ALPHA * x + ffn, ln2_g[layer], ln2_b[layer])
    return x
```

```cpp
#include <hip/hip_runtime.h>
#include <cstdio>
#include <cstdint>

#define LAS __attribute__((address_space(3)))
#define GAS __attribute__((address_space(1)))
typedef unsigned short bf16_t;
typedef short bf16x8 __attribute__((ext_vector_type(8)));
typedef short s16x4 __attribute__((ext_vector_type(4)));
typedef float f32x4 __attribute__((ext_vector_type(4)));
typedef float f32x2 __attribute__((ext_vector_type(2)));
typedef float f32x16 __attribute__((ext_vector_type(16)));
typedef unsigned u32x4 __attribute__((ext_vector_type(4)));
typedef unsigned u32x2 __attribute__((ext_vector_type(2)));
typedef int i32x2 __attribute__((ext_vector_type(2)));

constexpr int NB = 8, SEQ = 4096, DM = 1024, MTOK = NB * SEQ, FF = 3584, NEXP = 8;
constexpr int FOXH = 8, MOBAH = 16, EVEN_IN = 2056;
constexpr float ALPHA = 1.6817928305074290f;
constexpr float LN_EPS = 1e-5f;
constexpr float LOG2E = 1.4426950408889634f;
constexpr float C2 = 0.125f * 1.4426950408889634f;
constexpr int MAXROWS = 2 * MTOK + NEXP * 256;

typedef __bf16 bf16x2_t __attribute__((ext_vector_type(2)));
__device__ __forceinline__ unsigned cvt_pk_bf16(float lo, float hi) { const f32x2 v = {lo, hi}; const bf16x2_t b = __builtin_convertvector(v, bf16x2_t); return __builtin_bit_cast(unsigned, b); }
__device__ __forceinline__ float bf_lo(unsigned u) { return __uint_as_float(u << 16); }
__device__ __forceinline__ float bf_hi(unsigned u) { return __uint_as_float(u & 0xffff0000u); }

__device__ __forceinline__ int ls(int x) { asm volatile("" : "+s"(x)); return x; }
__device__ __forceinline__ float lane_xor(float v, int lane, int o) { return __int_as_float(__builtin_amdgcn_ds_bpermute((lane ^ o) << 2, __float_as_int(v))); }
__device__ __forceinline__ int fresh_tid() { int t = threadIdx.x; asm volatile("" : "+v"(t)); return t; }

namespace pg8 {
#define PG8_LAS __attribute__((address_space(3)))
constexpr int BM = 256, BK = 64, HALF = 128, HTB = HALF * BK * 2, STAGE_BYTES = 8 * HTB, NXCD = 8, WGM = 8;
__host__ __device__ __forceinline__ int lds_byte(int r, int c) { const int st = (r >> 4) * 2 + (c >> 5), rr = r & 15, cc = c & 31, ob = rr * 64 + cc * 2; return st * 1024 + (ob ^ (((ob >> 9) & 1) << 5)); }
__host__ __device__ __forceinline__ void stage_rc(int b, int& R, int& C) { const int st = b / 1024, sb = b % 1024, swz = sb ^ (((sb >> 9) & 1) << 5); R = (st >> 1) * 16 + swz / 64; C = (st & 1) * 32 + (swz % 64) / 2; }
__host__ __device__ __forceinline__ int perm32(int rho) { const int n = rho >> 4, i = rho & 15; return 8 * (i >> 2) + 4 * n + (i & 3); }

struct Unit { int pm, pn, pb; };
struct Gemm { const bf16_t* A; const bf16_t* Bt; int M, N, K; };

template <int NN> struct StaticOrderT {
    int nM, nwg, G, c;
    __device__ void init(int M, int  , int G_, int c_) { nM = M / BM; nwg = nM * NN; G = G_; c = c_; }
    __device__ bool next(int i, Unit& u) const {
        const int L = i * G + c; if (L >= nwg) return false;
        int wgid = L; { const int q = nwg / NXCD, r = nwg % NXCD, xcd = wgid % NXCD, off = wgid / NXCD; wgid = (xcd < r ? xcd * (q + 1) : r * (q + 1) + (xcd - r) * q) + off; }
        constexpr int nig = WGM * NN; const int gid = wgid / nig, fm = gid * WGM, rem = wgid % nig, left = nM - fm;
        if (left >= WGM) { u.pm = fm + rem % WGM; u.pn = rem / WGM; } else { u.pm = fm + rem % left; u.pn = rem / left; }
        u.pb = u.pn; return true;
    }
    __device__ __forceinline__ void a_ready(const Unit&) const {}
    __device__ __forceinline__ void done(const Unit&) const {}
};
template <int NN> struct MoeOrderT {
    int nM, nwg, G, c; const int* pe;
    __device__ void init(int nPanels, int  , int G_, int c_, const int* pe_) { nM = nPanels; nwg = nM * NN; G = G_; c = c_; pe = pe_; }
    __device__ bool next(int i, Unit& u) const {
        const int L = i * G + c; if (L >= nwg) return false;
        int wgid = L; { const int q = nwg / NXCD, r = nwg % NXCD, xcd = wgid % NXCD, off = wgid / NXCD; wgid = (xcd < r ? xcd * (q + 1) : r * (q + 1) + (xcd - r) * q) + off; }
        constexpr int nig = WGM * NN; const int gid = wgid / nig, fm = gid * WGM, rem = wgid % nig, left = nM - fm;
        if (left >= WGM) { u.pm = fm + rem % WGM; u.pn = rem / WGM; } else { u.pm = fm + rem % left; u.pn = rem / left; }
        u.pb = __builtin_amdgcn_readfirstlane(pe[u.pm]) * NN + u.pn; return true;
    }
    __device__ __forceinline__ void a_ready(const Unit&) const {}
    __device__ __forceinline__ void done(const Unit&) const {}
};

typedef int i32x4v __attribute__((ext_vector_type(4)));
typedef int i32x8v __attribute__((ext_vector_type(8)));
__device__ __forceinline__ i32x8v cat8(const bf16x8& lo, const bf16x8& hi) { const i32x4v a = __builtin_bit_cast(i32x4v, lo), b = __builtin_bit_cast(i32x4v, hi); return __builtin_shufflevector(a, b, 0, 1, 2, 3, 4, 5, 6, 7); }
template <bool F8> __device__ __forceinline__ void mma_block(f32x4 (&acc)[4][2], const bf16x8 (&At)[4][2], const bf16x8 (&Bt)[2][2], const i32x8v (&At8)[4], const i32x8v (&Bt8)[2]) {
    if constexpr (!F8) {
#pragma unroll
        for (int m = 0; m < 4; ++m)
#pragma unroll
            for (int n = 0; n < 2; ++n)
#pragma unroll
                for (int k = 0; k < 2; ++k) acc[m][n] = __builtin_amdgcn_mfma_f32_16x16x32_bf16(Bt[n][k], At[m][k], acc[m][n], 0, 0, 0);
    } else {
#pragma unroll
        for (int m = 0; m < 4; ++m)
#pragma unroll
            for (int n = 0; n < 2; ++n) asm volatile("v_mfma_scale_f32_16x16x128_f8f6f4 %0, %1, %2, %0, %3, %3 op_sel_hi:[0,0,0]" : "+v"(acc[m][n]) : "v"(Bt8[n]), "v"(At8[m]), "v"(0x7f7f7f7f));
    }
}

struct EpiBf16 {
    static constexpr bool PERM = true, AFTER_DRAIN = false;
    bf16_t* O; int ldc; int nscale; float scale0; float scale1 = 1.f;
    __device__ __forceinline__ void operator()(const f32x4 (&acc)[2][2][4][2], const Unit& u, int wr, int wc, int fr, int fq) const {
        asm volatile("" : "+v"(fr), "+v"(fq));
        const int row0 = u.pm * BM + wr * 64 + fr; const int col0 = u.pn * BM + wc * 32 + 8 * fq;
        const float sc = (u.pn < nscale) ? scale0 : scale1;
#pragma unroll
        for (int ai = 0; ai < 2; ++ai)
#pragma unroll
            for (int m = 0; m < 4; ++m) { bf16_t* rowp = O + (size_t)(row0 + ai * HALF + m * 16) * ldc + col0;
#pragma unroll
                for (int bj = 0; bj < 2; ++bj) { const f32x4 v0 = acc[ai][bj][m][0] * sc, v1 = acc[ai][bj][m][1] * sc;
                    u32x4 w; w.x = cvt_pk_bf16(v0[0], v0[1]); w.y = cvt_pk_bf16(v0[2], v0[3]); w.z = cvt_pk_bf16(v1[0], v1[1]); w.w = cvt_pk_bf16(v1[2], v1[3]);
                    *(u32x4*)(rowp + bj * HALF) = w; } }
    }
};
__device__ __forceinline__ float silu_mul(float g, float u) { const float e = __builtin_amdgcn_exp2f(-g * LOG2E); return g * __builtin_amdgcn_rcpf(1.0f + e) * u; }
struct EpiSwiGLU {
    static constexpr bool PERM = true, AFTER_DRAIN = false;
    bf16_t* O; int ldc;
    __device__ __forceinline__ void operator()(const f32x4 (&acc)[2][2][4][2], const Unit& u, int wr, int wc, int fr, int fq) const {
        asm volatile("" : "+v"(fr), "+v"(fq));
        const int row0 = u.pm * BM + wr * 64 + fr; const int col0 = u.pn * HALF + wc * 32 + 8 * fq;
#pragma unroll
        for (int ai = 0; ai < 2; ++ai)
#pragma unroll
            for (int m = 0; m < 4; ++m) { bf16_t* rowp = O + (size_t)(row0 + ai * HALF + m * 16) * ldc + col0;
                const f32x4 g0 = acc[ai][0][m][0], g1 = acc[ai][0][m][1], u0 = acc[ai][1][m][0], u1 = acc[ai][1][m][1];
                u32x4 w; w.x = cvt_pk_bf16(silu_mul(g0[0], u0[0]), silu_mul(g0[1], u0[1])); w.y = cvt_pk_bf16(silu_mul(g0[2], u0[2]), silu_mul(g0[3], u0[3]));
                w.z = cvt_pk_bf16(silu_mul(g1[0], u1[0]), silu_mul(g1[1], u1[1])); w.w = cvt_pk_bf16(silu_mul(g1[2], u1[2]), silu_mul(g1[3], u1[3]));
                *(u32x4*)rowp = w; }
    }
};
__device__ __forceinline__ float clamp448(float x) { return fminf(fmaxf(x, -448.f), 448.f); }
__device__ __forceinline__ unsigned pack4_fp8(float a, float b, float c, float d) { int w = 0; w = __builtin_amdgcn_cvt_pk_fp8_f32(clamp448(a), clamp448(b), w, false); w = __builtin_amdgcn_cvt_pk_fp8_f32(clamp448(c), clamp448(d), w, true); return (unsigned)w; }
struct EpiSwiGLU8 {
    static constexpr bool PERM = true, AFTER_DRAIN = false;
    unsigned char* O; int ldc; float inscale, outscale;
    __device__ __forceinline__ void operator()(const f32x4 (&acc)[2][2][4][2], const Unit& u, int wr, int wc, int fr, int fq) const {
        asm volatile("" : "+v"(fr), "+v"(fq));
        const int row0 = u.pm * BM + wr * 64 + fr; const int col0 = u.pn * HALF + wc * 32 + 8 * fq;
        const float os = outscale * inscale;
#pragma unroll
        for (int ai = 0; ai < 2; ++ai)
#pragma unroll
            for (int m = 0; m < 4; ++m) { unsigned char* rowp = O + (size_t)(row0 + ai * HALF + m * 16) * ldc + col0;
                const f32x4 g0 = acc[ai][0][m][0] * inscale, g1 = acc[ai][0][m][1] * inscale, u0 = acc[ai][1][m][0] * os, u1 = acc[ai][1][m][1] * os;
                u32x2 w; w.x = pack4_fp8(silu_mul(g0[0], u0[0]), silu_mul(g0[1], u0[1]), silu_mul(g0[2], u0[2]), silu_mul(g0[3], u0[3]));
                w.y = pack4_fp8(silu_mul(g1[0], u1[0]), silu_mul(g1[1], u1[1]), silu_mul(g1[2], u1[2]), silu_mul(g1[3], u1[3]));
                *(u32x2*)rowp = w; }
    }
};
struct EpiResid {
    static constexpr bool PERM = true, AFTER_DRAIN = false;
    const bf16_t* base; bf16_t* out; int ldc; float alpha, accscale;
    __device__ __forceinline__ void operator()(const f32x4 (&acc)[2][2][4][2], const Unit& u, int wr, int wc, int fr, int fq) const {
        asm volatile("" : "+v"(fr), "+v"(fq));
        const int row0 = u.pm * BM + wr * 64 + fr; const int col0 = u.pn * BM + wc * 32 + 8 * fq;
#pragma unroll
        for (int ai = 0; ai < 2; ++ai)
#pragma unroll
            for (int m = 0; m < 4; ++m) { const size_t off = (size_t)(row0 + ai * HALF + m * 16) * ldc + col0;
                u32x4 bs[2];
#pragma unroll
                for (int bj = 0; bj < 2; ++bj) bs[bj] = *(const u32x4*)(base + off + bj * HALF);
#pragma unroll
                for (int bj = 0; bj < 2; ++bj) { const f32x4 v0 = acc[ai][bj][m][0] * accscale, v1 = acc[ai][bj][m][1] * accscale; const u32x4 b = bs[bj];
                    u32x4 w; w.x = cvt_pk_bf16(bf_lo(b.x) * alpha + v0[0], bf_hi(b.x) * alpha + v0[1]); w.y = cvt_pk_bf16(bf_lo(b.y) * alpha + v0[2], bf_hi(b.y) * alpha + v0[3]);
                    w.z = cvt_pk_bf16(bf_lo(b.z) * alpha + v1[0], bf_hi(b.z) * alpha + v1[1]); w.w = cvt_pk_bf16(bf_lo(b.w) * alpha + v1[2], bf_hi(b.w) * alpha + v1[3]);
                    *(u32x4*)(out + off + bj * HALF) = w; }
                asm volatile("" ::: "memory"); }
    }
};
template <class Epi, class Sched, bool ALIGN_EPI = false, bool SP2 = false, bool F8 = false>
__device__ __forceinline__ void gemm_phase(PG8_LAS unsigned char* lds, const Gemm g, const Sched& S, const Epi& E) {
    const int tid = fresh_tid(), wid = __builtin_amdgcn_readfirstlane(tid >> 6), lane = tid & 63, wr = wid >> 2, wc = wid & 3, fr = lane & 15, fq = lane >> 4;
    const int K = g.K, nt = K / BK;
    unsigned voffA[2], voffB[2];
#pragma unroll
    for (int i = 0; i < 2; ++i) { int R, C; stage_rc(tid * 16 + i * 8192, R, C); const int Rb = Epi::PERM ? ((R & ~31) + perm32(R & 31)) : R;
        voffA[i] = (unsigned)(R * K + C) * 2u; voffB[i] = (unsigned)(Rb * K + C) * 2u; }
    const size_t kstep = (size_t)(BK * 2);
    const size_t hstep = (size_t)HALF * K * 2;
    const size_t tstep = 2 * hstep;
    const unsigned ldsw = (unsigned)wid * 1024u;
    const int aoff = lds_byte(wr * 64 + fr, fq * 8), boff = lds_byte(wc * 32 + fr, fq * 8);
#define PG8_SA(b, h) (((b) * 2 + (h)) * HTB)
#define PG8_SB(b, h) ((4 + (b) * 2 + (h)) * HTB)
#define PG8_STAGE(bufoff, gbase, voff) do { _Pragma("unroll") for (int _i = 0; _i < 2; ++_i) \
        __builtin_amdgcn_global_load_lds((const unsigned*)((const char*)(gbase) + (voff)[_i]), (PG8_LAS unsigned*)(lds + (bufoff) + ldsw + _i * 8192), 16, 0, 0); } while (0)
#define PG8_LDA(dst, b, h) do { if constexpr (!F8) { _Pragma("unroll") for (int m = 0; m < 4; ++m) _Pragma("unroll") for (int k = 0; k < 2; ++k) dst[m][k] = *(const PG8_LAS bf16x8*)(lds + PG8_SA(b, h) + aoff + m * 2048 + k * 1024); } \
        else { _Pragma("unroll") for (int m = 0; m < 4; ++m) { const i32x4v lo_ = *(const PG8_LAS i32x4v*)(lds + PG8_SA(b, h) + aoff + m * 2048), hi_ = *(const PG8_LAS i32x4v*)(lds + PG8_SA(b, h) + aoff + m * 2048 + 1024); dst##8[m] = __builtin_shufflevector(lo_, hi_, 0, 1, 2, 3, 4, 5, 6, 7); } } } while (0)
#define PG8_LDB(dst, b, h) do { if constexpr (!F8) { _Pragma("unroll") for (int n = 0; n < 2; ++n) _Pragma("unroll") for (int k = 0; k < 2; ++k) dst[n][k] = *(const PG8_LAS bf16x8*)(lds + PG8_SB(b, h) + boff + n * 2048 + k * 1024); } \
        else { _Pragma("unroll") for (int n = 0; n < 2; ++n) { const i32x4v lo_ = *(const PG8_LAS i32x4v*)(lds + PG8_SB(b, h) + boff + n * 2048), hi_ = *(const PG8_LAS i32x4v*)(lds + PG8_SB(b, h) + boff + n * 2048 + 1024); dst##8[n] = __builtin_shufflevector(lo_, hi_, 0, 1, 2, 3, 4, 5, 6, 7); } } } while (0)
#define PG8_MMA(ai, bj, At, Bt) do { __builtin_amdgcn_s_setprio(1); mma_block<F8>(acc[ai][bj], At, Bt, At##8, Bt##8); __builtin_amdgcn_s_setprio(0); } while (0)
#define PG8_WAIT_V(n) asm volatile("s_waitcnt vmcnt(" #n ")" ::: "memory")
#define PG8_WAIT_L(n) asm volatile("s_waitcnt lgkmcnt(" #n ")" ::: "memory")
#define PG8_BAR __builtin_amdgcn_s_barrier()
#define PG8_SCHED __builtin_amdgcn_sched_barrier(0)
    Unit cur, nxt; int ui = 0;
    if (!S.next(0, cur)) return;
    f32x4 acc[2][2][4][2];
#pragma unroll
    for (int a = 0; a < 2; ++a)
#pragma unroll
        for (int b = 0; b < 2; ++b)
#pragma unroll
            for (int m = 0; m < 4; ++m)
#pragma unroll
                for (int n = 0; n < 2; ++n) acc[a][b][m][n] = (f32x4){0.f, 0.f, 0.f, 0.f};
    bf16x8 At[4][2], B0[2][2], B1[2][2];
    i32x8v At8[4], B08[2], B18[2];
    const char* cA = (const char*)g.A + (size_t)cur.pm * tstep; const char* cB = (const char*)g.Bt + (size_t)cur.pb * tstep;
    S.a_ready(cur);
    if constexpr (SP2) {
        PG8_STAGE(PG8_SB(0, 0), cB, voffB); PG8_STAGE(PG8_SB(0, 1), cB + hstep, voffB); PG8_STAGE(PG8_SA(0, 0), cA, voffA); PG8_STAGE(PG8_SA(0, 1), cA + hstep, voffA);
        if (wr == 1) PG8_BAR;
        PG8_WAIT_V(2); PG8_BAR;
        PG8_STAGE(PG8_SB(1, 0), cB + kstep, voffB); PG8_STAGE(PG8_SA(1, 0), cA + kstep, voffA); PG8_STAGE(PG8_SB(1, 1), cB + hstep + kstep, voffB);
        PG8_WAIT_V(6); PG8_BAR;
    } else {
        PG8_STAGE(PG8_SB(0, 0), cB, voffB); PG8_STAGE(PG8_SA(0, 0), cA, voffA); PG8_STAGE(PG8_SB(0, 1), cB + hstep, voffB); PG8_STAGE(PG8_SA(0, 1), cA + hstep, voffA);
        if (wr == 1) PG8_BAR;
        PG8_WAIT_V(4); PG8_BAR;
        PG8_STAGE(PG8_SB(1, 0), cB + kstep, voffB); PG8_STAGE(PG8_SA(1, 0), cA + kstep, voffA); PG8_STAGE(PG8_SB(1, 1), cB + hstep + kstep, voffB);
        PG8_WAIT_V(6); PG8_BAR;
    }
    for (;;) {
        const bool has_next = S.next(ui + 1, nxt);
        const char* nA = has_next ? (const char*)g.A + (size_t)nxt.pm * tstep : cA; const char* nB = has_next ? (const char*)g.Bt + (size_t)nxt.pb * tstep : cB;
        for (int t = 0; t < nt; t += 2) {
            const bool last = (t == nt - 2);
            const char* a1 = cA + (size_t)(t + 1) * kstep;
            const char* a2 = last ? nA : cA + (size_t)(t + 2) * kstep; const char* b2 = last ? nB : cB + (size_t)(t + 2) * kstep;
            const char* a3 = a2 + kstep; const char* b3 = b2 + kstep;
            if (last && has_next) S.a_ready(nxt);
            if constexpr (SP2) {
            PG8_LDB(B0, 0, 0); PG8_LDB(B1, 0, 1); PG8_SCHED; PG8_LDA(At, 0, 0); PG8_STAGE(PG8_SA(1, 1), a1 + hstep, voffA);
            PG8_WAIT_V(8); PG8_WAIT_L(0); PG8_BAR; PG8_MMA(0, 0, At, B0); PG8_MMA(0, 1, At, B1); PG8_BAR; PG8_SCHED;
            PG8_LDA(At, 0, 1); PG8_STAGE(PG8_SB(0, 0), b2, voffB); PG8_STAGE(PG8_SB(0, 1), b2 + hstep, voffB); PG8_STAGE(PG8_SA(0, 0), a2, voffA);
            PG8_WAIT_V(8); PG8_WAIT_L(0); PG8_BAR; PG8_MMA(1, 0, At, B0); PG8_MMA(1, 1, At, B1); PG8_BAR; PG8_SCHED;
            PG8_LDB(B0, 1, 0); PG8_LDB(B1, 1, 1); PG8_SCHED; PG8_LDA(At, 1, 0); PG8_STAGE(PG8_SA(0, 1), a2 + hstep, voffA);
            PG8_WAIT_V(8); PG8_WAIT_L(0); PG8_BAR; PG8_MMA(0, 0, At, B0); PG8_MMA(0, 1, At, B1); PG8_BAR; PG8_SCHED;
            PG8_LDA(At, 1, 1); PG8_STAGE(PG8_SB(1, 0), b3, voffB); PG8_STAGE(PG8_SB(1, 1), b3 + hstep, voffB); PG8_STAGE(PG8_SA(1, 0), a3, voffA);
            PG8_WAIT_V(8); PG8_WAIT_L(0); PG8_BAR; PG8_MMA(1, 0, At, B0); PG8_MMA(1, 1, At, B1); PG8_BAR; PG8_SCHED;
            } else {
            PG8_LDB(B0, 0, 0); PG8_SCHED; PG8_LDA(At, 0, 0); PG8_STAGE(PG8_SA(1, 1), a1 + hstep, voffA);
            PG8_WAIT_L(8); PG8_BAR; PG8_WAIT_L(0); PG8_MMA(0, 0, At, B0); PG8_BAR; PG8_SCHED;
            PG8_LDB(B1, 0, 1); PG8_STAGE(PG8_SB(0, 0), b2, voffB);
            PG8_BAR; PG8_WAIT_L(0); PG8_MMA(0, 1, At, B1); PG8_BAR;
            PG8_LDA(At, 0, 1); PG8_STAGE(PG8_SA(0, 0), a2, voffA);
            PG8_BAR; PG8_WAIT_L(0); PG8_MMA(1, 0, At, B0); PG8_BAR; PG8_SCHED;
            PG8_STAGE(PG8_SB(0, 1), b2 + hstep, voffB);
            PG8_WAIT_V(6); PG8_BAR; PG8_MMA(1, 1, At, B1); PG8_BAR;
            PG8_LDB(B0, 1, 0); PG8_SCHED; PG8_LDA(At, 1, 0); PG8_STAGE(PG8_SA(0, 1), a2 + hstep, voffA);
            PG8_WAIT_L(8); PG8_BAR; PG8_WAIT_L(0); PG8_MMA(0, 0, At, B0); PG8_BAR; PG8_SCHED;
            PG8_LDB(B1, 1, 1); PG8_STAGE(PG8_SB(1, 0), b3, voffB);
            PG8_BAR; PG8_WAIT_L(0); PG8_MMA(0, 1, At, B1); PG8_BAR;
            PG8_LDA(At, 1, 1); PG8_STAGE(PG8_SA(1, 0), a3, voffA);
            PG8_BAR; PG8_WAIT_L(0); PG8_MMA(1, 0, At, B0); PG8_BAR; PG8_SCHED;
            PG8_STAGE(PG8_SB(1, 1), b3 + hstep, voffB);
            PG8_WAIT_V(6); PG8_BAR; PG8_MMA(1, 1, At, B1); PG8_BAR;
            }
        }
        if constexpr (F8) asm volatile("s_nop 15\n\ts_nop 15" ::: "memory");
        if constexpr (ALIGN_EPI) { if (wr == 0) PG8_BAR; }
        if constexpr (!Epi::AFTER_DRAIN) { E(acc, cur, wr, wc, fr, fq); S.done(cur); }
        if (!has_next) break;
#pragma unroll
        for (int a = 0; a < 2; ++a)
#pragma unroll
            for (int b = 0; b < 2; ++b)
#pragma unroll
                for (int m = 0; m < 4; ++m)
#pragma unroll
                    for (int n = 0; n < 2; ++n) acc[a][b][m][n] = (f32x4){0.f, 0.f, 0.f, 0.f};
        cur = nxt; cA = nA; cB = nB; ++ui;
        if constexpr (ALIGN_EPI) { if (wr == 1) PG8_BAR; }
    }
    PG8_WAIT_V(0);
    if constexpr (!ALIGN_EPI) { if (wr == 0) PG8_BAR; }
    PG8_BAR;
    if constexpr (Epi::AFTER_DRAIN) { E.fused(acc, cur, wr, wc, fr, fq, lds, wid, lane); S.done(cur); }
#undef PG8_SA
#undef PG8_SB
#undef PG8_STAGE
#undef PG8_LDA
#undef PG8_LDB
#undef PG8_MMA
#undef PG8_WAIT_V
#undef PG8_WAIT_L
#undef PG8_BAR
#undef PG8_SCHED
}
}

constexpr size_t MiB = 1u << 20;
constexpr size_t WS_CTL = 0, CTL_ZERO_BYTES = 256 * 1024;
constexpr size_t WS_LOGF = 4 * MiB;
constexpr size_t WS_FL = 5 * MiB;
constexpr size_t WS_KMEAN = 6 * MiB;
constexpr size_t WS_RE = 7 * MiB;
constexpr size_t WS_RG = 7 * MiB + 256 * 1024;
constexpr size_t WS_RR = 7 * MiB + 512 * 1024;
constexpr size_t WS_POS = 7 * MiB + 768 * 1024;
constexpr size_t WS_CNT = 8 * MiB;
constexpr size_t WS_PB = 8 * MiB + 64 * 1024;
constexpr size_t WS_W = 16 * MiB;
constexpr size_t WS_XB = 192 * MiB;
constexpr size_t WS_BIG = 256 * MiB;
constexpr size_t WS_XS = 718 * MiB;
constexpr size_t WS_END = 850 * MiB;
static_assert(WS_BIG + (size_t)MAXROWS * FF * 2 <= WS_XS && WS_XS + (size_t)MAXROWS * DM * 2 <= WS_END, "d_ws map");
constexpr size_t WE_IN = 0, WE_OUT = 4 * MiB, WE_GU = 6 * MiB, WE_DN = 20 * MiB, WE_POOL = 27 * MiB;
constexpr size_t WO_IN = 28 * MiB, WO_OUT = 34 * MiB, WO_GU = 36 * MiB, WO_DN = 92 * MiB;
constexpr float S8_X = 16.f, S8_WGU = 256.f, S8_H = 8.f, S8_WDN = 1024.f;
constexpr size_t BG_HC = 0, BG_CAT = 192 * MiB, BG_HID = 0, BG_XS8 = 320 * MiB, BG_XB8 = 128 * MiB;
constexpr int CW_BAR = 1024;

constexpr int RING_BYTES = 131072;
constexpr int MISC_OFF = RING_BYTES;
constexpr int LDS_BYTES = 147456;

typedef GAS unsigned gu32;
#define RLX_AGENT __ATOMIC_RELAXED, __HIP_MEMORY_SCOPE_AGENT
#define LDS_WAIT() asm volatile("s_waitcnt lgkmcnt(0)" ::: "memory")
#define XB_TMO      128
#define XB_XCNT(j)  (256  + 64 * (j))
#define XB_XSUB(j)  (1280 + 64 * (j))
#define XB_XGEN(j)  (2304 + 64 * (j))
#define XB_TOP      3328
#define XB_TOPGEN   3392
#define XCD_BAR_WORDS 3456
#define XB_SPIN_CAP (1u << 18)

__device__ __forceinline__ unsigned xb_ld(unsigned* p)              { return __hip_atomic_load(p, __ATOMIC_RELAXED, __HIP_MEMORY_SCOPE_AGENT); }
__device__ __forceinline__ unsigned xb_add(unsigned* p, unsigned v) { return __hip_atomic_fetch_add(p, v, __ATOMIC_RELAXED, __HIP_MEMORY_SCOPE_AGENT); }
__device__ __forceinline__ unsigned xb_xcc_id() { return (unsigned)__builtin_amdgcn_s_getreg((3 << 11) | 20) & 0xFu; }
#define XB_SPIN(cond, bar) do { unsigned _sp = 0; while (cond) { __builtin_amdgcn_s_sleep(1); \
    if ((++_sp & 255u) == 0u) { if (xb_ld(&(bar)[XB_TMO])) break; if (_sp > XB_SPIN_CAP) { atomicAdd(&(bar)[XB_TMO], 1u); break; } } } } while (0)

struct XcdBarrier {
    unsigned* bar; unsigned x;
    volatile LAS unsigned* st;
};

__device__ __forceinline__ XcdBarrier xcd_barrier_post(unsigned* bar, volatile LAS unsigned* st) {
    XcdBarrier b; b.bar = bar; b.x = xb_xcc_id(); b.st = st;
    if (threadIdx.x == 0) (void)xb_add(&bar[XB_XCNT(b.x)], 1u);
    return b;
}
__device__ __forceinline__ void xcd_barrier_complete(unsigned* bar, unsigned x, unsigned& nloc, unsigned& nx) {
    const unsigned G = gridDim.x * gridDim.y * gridDim.z;
    unsigned sum, cnt, mine, sp = 0u;
    for (;;) {
        sum = 0u; cnt = 0u; mine = 0u;
#pragma unroll
        for (unsigned j = 0; j < 16; ++j) { const unsigned c = xb_ld(&bar[XB_XCNT(j)]); sum += c; cnt += (c > 0u) ? 1u : 0u; mine = (j == x) ? c : mine; }
        if (sum == G) break;
        __builtin_amdgcn_s_sleep(1);
        if ((++sp & 255u) == 0u) { if (xb_ld(&bar[XB_TMO])) break; if (sp > XB_SPIN_CAP) { atomicAdd(&bar[XB_TMO], 1u); break; } }
    }
    nloc = mine > 0u ? mine : 1u; nx = cnt > 0u ? cnt : 1u;
}

__device__ __forceinline__ void xcd_barrier(const XcdBarrier& b) {
    asm volatile("s_waitcnt vmcnt(0)" ::: "memory");
    __syncthreads();
    if (threadIdx.x == 0) {
        unsigned* bar = b.bar;
        __builtin_amdgcn_s_waitcnt(0);
        unsigned nloc = b.st[0], nx = b.st[1];
        if (nloc == 0u) { xcd_barrier_complete(bar, b.x, nloc, nx); b.st[0] = nloc; b.st[1] = nx; }
        const unsigned old = xb_add(&bar[XB_XSUB(b.x)], 1u);
        const unsigned gen = old / nloc;
        if (old + 1u == (gen + 1u) * nloc) {
            __builtin_amdgcn_fence(__ATOMIC_RELEASE, "agent");
            asm volatile("s_waitcnt vmcnt(0)" ::: "memory");
            const unsigned og = xb_add(&bar[XB_TOP], 1u);
            const unsigned tg = og / nx;
            if (og + 1u == (tg + 1u) * nx) xb_add(&bar[XB_TOPGEN], 1u);
            else XB_SPIN(xb_ld(&bar[XB_TOPGEN]) == tg, bar);
            __builtin_amdgcn_fence(__ATOMIC_ACQUIRE, "agent");
            xb_add(&bar[XB_XGEN(b.x)], 1u);
            asm volatile("s_waitcnt vmcnt(0)" ::: "memory");
        } else {
            XB_SPIN(xb_ld(&bar[XB_XGEN(b.x)]) == gen, bar);
            __builtin_amdgcn_fence(__ATOMIC_ACQUIRE, "agent");
            asm volatile("s_waitcnt vmcnt(0)" ::: "memory");
        }
    }
    __syncthreads();
}

__device__ __forceinline__ float wave_sum(float v, int lane) {
#pragma unroll
    for (int o = 1; o < 64; o <<= 1) v += lane_xor(v, lane, o);
    return v;
}
__device__ __forceinline__ void transpose_item(const float* W, int K, int ld, int col0, int N, bf16_t* WT, int mode, int rowoff, const float* scale, LAS float* scr, int item, int lane) {
    const int nblk = N / 32, kb = item / nblk, nb = item % nblk, k0 = 64 * kb, n0 = 32 * nb;
    float tv[32];
#pragma unroll
    for (int i = 0; i < 32; ++i) { const int kk = 2 * i + (lane >> 5); tv[i] = __builtin_nontemporal_load(W + (size_t)(k0 + kk) * ld + col0 + n0 + (lane & 31)); }
    __builtin_amdgcn_sched_barrier(0);
#pragma unroll
    for (int i = 0; i < 32; ++i) { const int kk = 2 * i + (lane >> 5); scr[kk * 33 + (lane & 31)] = tv[i]; }
    LDS_WAIT(); asm volatile("" ::: "memory");
    const int c = lane & 7;
    const int r0 = (mode == 0) ? (rowoff + n0) : (256 * (n0 >> 7) + (n0 & 127) + rowoff);
#pragma unroll
    for (int j = 0; j < 4; ++j) { const int n = (lane >> 3) + 8 * j; const LAS float* s = scr + (8 * c) * 33 + n;
        const float sc = scale ? scale[n0 + n] : 1.f;
        u32x4 o; o.x = cvt_pk_bf16(s[0 * 33] * sc, s[1 * 33] * sc); o.y = cvt_pk_bf16(s[2 * 33] * sc, s[3 * 33] * sc); o.z = cvt_pk_bf16(s[4 * 33] * sc, s[5 * 33] * sc); o.w = cvt_pk_bf16(s[6 * 33] * sc, s[7 * 33] * sc);
        *(u32x4*)(WT + (size_t)(r0 + n) * K + k0 + 8 * c) = o; }
    LDS_WAIT(); asm volatile("" ::: "memory");
}
constexpr int T8_PITCH = 136;
__device__ __forceinline__ void transpose_item8(const float* W, int K, int ld, int N, unsigned char* WT, int mode, int rowoff, float mul, LAS unsigned char* scr, int item, int lane) {
    const int nblk = N / 64, kb = item / nblk, nb = item % nblk, k0 = 128 * kb, n0 = 64 * nb;
    const int g = lane >> 4, l16 = lane & 15;
    const float* src = W + (size_t)(k0 + 2 * g) * ld + n0 + 4 * l16;
    f32x4 ra[16], rb[16];
#pragma unroll
    for (int it = 0; it < 16; ++it) { ra[it] = __builtin_nontemporal_load((const f32x4*)(src + (size_t)(8 * it) * ld)); rb[it] = __builtin_nontemporal_load((const f32x4*)(src + (size_t)(8 * it + 1) * ld)); }
    __builtin_amdgcn_sched_barrier(0);
#pragma unroll
    for (int it = 0; it < 16; ++it) {
        const f32x4 a = ra[it] * mul, b = rb[it] * mul;
        int w0 = 0, w1 = 0;
        w0 = __builtin_amdgcn_cvt_pk_fp8_f32(pg8::clamp448(a.x), pg8::clamp448(b.x), w0, false); w0 = __builtin_amdgcn_cvt_pk_fp8_f32(pg8::clamp448(a.y), pg8::clamp448(b.y), w0, true);
        w1 = __builtin_amdgcn_cvt_pk_fp8_f32(pg8::clamp448(a.z), pg8::clamp448(b.z), w1, false); w1 = __builtin_amdgcn_cvt_pk_fp8_f32(pg8::clamp448(a.w), pg8::clamp448(b.w), w1, true);
        *(LAS u32x2*)(scr + (4 * it + g) * T8_PITCH + l16 * 8) = (u32x2){(unsigned)w0, (unsigned)w1};
    }
    LDS_WAIT(); asm volatile("" ::: "memory");
    const int r0 = (mode == 0) ? (rowoff + n0) : (256 * (n0 >> 7) + (n0 & 127) + rowoff);
    const LAS unsigned char* rd = scr + (l16 >> 2) * T8_PITCH + (l16 & 3) * 8;
#pragma unroll
    for (int t = 0; t < 8; ++t) { const int cb = t >> 1, piece = (t & 1) * 4 + g;
        const LAS unsigned char* p = rd + (piece * 8) * T8_PITCH + cb * 32;
        const s16x4 lo = __builtin_bit_cast(s16x4, __builtin_amdgcn_ds_read_tr16_b64_v4i16((LAS s16x4*)p)), hi = __builtin_bit_cast(s16x4, __builtin_amdgcn_ds_read_tr16_b64_v4i16((LAS s16x4*)(p + 4 * T8_PITCH)));
        const u32x2 l2 = __builtin_bit_cast(u32x2, lo), h2 = __builtin_bit_cast(u32x2, hi);
        *(u32x4*)(WT + (size_t)(r0 + cb * 16 + l16) * K + k0 + piece * 16) = (u32x4){l2.x, l2.y, h2.x, h2.y}; }
    LDS_WAIT(); asm volatile("" ::: "memory");
}
__device__ __forceinline__ void conv_job8(const float* W, size_t wstride, int K, int ld, int N, unsigned char* WT, size_t tstride, int mode, int rowoff, float mul, int nbatch,
                                          LAS unsigned char* scr, int gw, int NGW, int lane, int& base) {
    const int per = (K / 128) * (N / 64), total = per * nbatch;
    int first = (gw - base) % NGW; if (first < 0) first += NGW;
    for (int it = first; it < total; it += NGW) { const int bi = it / per, r = it - bi * per;
        transpose_item8(W + bi * wstride, K, ld, N, WT + bi * tstride, mode, rowoff, mul, scr, r, lane); }
    base = (base + total) % NGW;
}
__device__ __forceinline__ void conv_job(const float* W, size_t wstride, int K, int ld, int col0, int N, bf16_t* WT, size_t tstride, int mode, int rowoff, const float* scale, size_t sstride, int nbatch,
                                         LAS float* scr, int gw, int NGW, int lane, int& base) {
    const int per = (K / 64) * (N / 32), total = per * nbatch;
    int first = (gw - base) % NGW; if (first < 0) first += NGW;
    for (int it = first; it < total; it += NGW) { const int bi = it / per, r = it - bi * per;
        transpose_item(W + bi * wstride, K, ld, col0, N, WT + bi * tstride, mode, rowoff, scale ? scale + bi * sstride : nullptr, scr, r, lane); }
    base = (base + total) % NGW;
}

__device__ __forceinline__ float wave_sum_dpp(float v) {
    v += __int_as_float(__builtin_amdgcn_update_dpp(0, __float_as_int(v), 0xB1, 0xf, 0xf, false));
    v += __int_as_float(__builtin_amdgcn_update_dpp(0, __float_as_int(v), 0x4E, 0xf, 0xf, false));
    v += __int_as_float(__builtin_amdgcn_update_dpp(0, __float_as_int(v), 0x141, 0xf, 0xf, false));
    v += __int_as_float(__builtin_amdgcn_update_dpp(0, __float_as_int(v), 0x140, 0xf, 0xf, false));
    { auto r = __builtin_amdgcn_permlane16_swap(__float_as_uint(v), __float_as_uint(v), false, false); v = __uint_as_float(r[0]) + __uint_as_float(r[1]); }
    { auto r = __builtin_amdgcn_permlane32_swap(__float_as_uint(v), __float_as_uint(v), false, false); v = __uint_as_float(r[0]) + __uint_as_float(r[1]); }
    return v;
}
enum { RP_LN = 1, RP_COMBINE = 2, RP_FORGET = 4, RP_ROUTER = 8, RP_WRITE_XF = 16, RP_SRC_BF16 = 32, RP_WRITE_X8 = 64 };
template <int FLAGS>
__device__ __forceinline__ void row_phase(LAS unsigned char* lds, int chunk,
        const float* src, float* XF, bf16_t* XB, const float* gam, const float* bet,
        const float* w8, int w8ld, const float* bfg, float* LOGF,
        const bf16_t* YB, const f32x2* RG_in, const i32x2* POS_in,
        unsigned* RE, f32x2* RG, unsigned* RR, int* CNT, unsigned char* X8 = nullptr) {
    constexpr int RB = ((FLAGS & RP_COMBINE) && (FLAGS & RP_FORGET)) ? 2 : 4;
    const int tid = fresh_tid(), lane = tid & 63, wave = __builtin_amdgcn_readfirstlane(tid >> 6);
    LAS float* w8s = (LAS float*)lds;
    volatile LAS int* hist = (volatile LAS int*)(lds + MISC_OFF + 64);
    if (FLAGS & (RP_FORGET | RP_ROUTER)) {
        float wt[16];
#pragma unroll
        for (int j = 0; j < 16; ++j) { const int i = tid + 512 * j; wt[j] = w8[(size_t)(i >> 3) * w8ld + (i & 7)]; }
        __builtin_amdgcn_sched_barrier(0);
#pragma unroll
        for (int j = 0; j < 16; ++j) { const int i = tid + 512 * j; w8s[(i & 7) * 1024 + (i >> 3)] = wt[j]; }
        if (tid < 8) hist[tid] = 0;
        __syncthreads();
    }
    f32x4 gv[4], bv[4];
    if (FLAGS & RP_LN) {
#pragma unroll
        for (int j = 0; j < 4; ++j) { gv[j] = ((const f32x4*)gam)[lane + 64 * j]; bv[j] = ((const f32x4*)bet)[lane + 64 * j]; }
    }
    for (int it = 0; it < 16 / RB; ++it) {
        const int m0 = chunk * 128 + wave * 16 + it * RB;
        f32x4 v[RB][4]; u32x2 raw[RB][4]; u32x2 ya[RB][4], yb[RB][4]; f32x2 gg[RB];
        if (FLAGS & RP_COMBINE) {
            i32x2 pp[RB];
#pragma unroll
            for (int r = 0; r < RB; ++r) { gg[r] = RG_in[m0 + r]; pp[r] = POS_in[m0 + r]; }
#pragma unroll
            for (int r = 0; r < RB; ++r) { const u32x2* y0 = (const u32x2*)(YB + (size_t)pp[r].x * DM); const u32x2* y1 = (const u32x2*)(YB + (size_t)pp[r].y * DM);
#pragma unroll
                for (int j = 0; j < 4; ++j) { ya[r][j] = __builtin_nontemporal_load(y0 + lane + 64 * j); yb[r][j] = __builtin_nontemporal_load(y1 + lane + 64 * j); } }
        }
        if (FLAGS & RP_SRC_BF16) {
#pragma unroll
            for (int r = 0; r < RB; ++r)
#pragma unroll
                for (int j = 0; j < 4; ++j) raw[r][j] = __builtin_nontemporal_load((const u32x2*)((const bf16_t*)src + (size_t)(m0 + r) * DM) + lane + 64 * j);
        } else {
#pragma unroll
            for (int r = 0; r < RB; ++r)
#pragma unroll
                for (int j = 0; j < 4; ++j) v[r][j] = __builtin_nontemporal_load((const f32x4*)(src + (size_t)(m0 + r) * DM) + lane + 64 * j);
        }
        __builtin_amdgcn_sched_barrier(0);
        if (FLAGS & RP_SRC_BF16) {
#pragma unroll
            for (int r = 0; r < RB; ++r)
#pragma unroll
                for (int j = 0; j < 4; ++j) { const u32x2 w = raw[r][j]; v[r][j] = (f32x4){bf_lo(w.x), bf_hi(w.x), bf_lo(w.y), bf_hi(w.y)}; }
        }
        if (FLAGS & RP_COMBINE) {
#pragma unroll
            for (int r = 0; r < RB; ++r)
#pragma unroll
                for (int j = 0; j < 4; ++j) { const u32x2 a = ya[r][j], b = yb[r][j];
                    const f32x4 fa = {bf_lo(a.x), bf_hi(a.x), bf_lo(a.y), bf_hi(a.y)}, fb = {bf_lo(b.x), bf_hi(b.x), bf_lo(b.y), bf_hi(b.y)};
                    v[r][j] = v[r][j] * ALPHA + (fa * gg[r].x + fb * gg[r].y); }
        }
        if (FLAGS & RP_LN) {
            float mean[RB], rstd[RB];
#pragma unroll
            for (int r = 0; r < RB; ++r) { float s = 0.f;
#pragma unroll
                for (int j = 0; j < 4; ++j) s += (v[r][j].x + v[r][j].y) + (v[r][j].z + v[r][j].w);
                mean[r] = wave_sum_dpp(s) * (1.f / DM); }
#pragma unroll
            for (int r = 0; r < RB; ++r) { float s2 = 0.f;
#pragma unroll
                for (int j = 0; j < 4; ++j) { v[r][j] = v[r][j] - mean[r]; s2 += (v[r][j].x * v[r][j].x + v[r][j].y * v[r][j].y) + (v[r][j].z * v[r][j].z + v[r][j].w * v[r][j].w); }
                rstd[r] = 1.f / sqrtf(wave_sum_dpp(s2) * (1.f / DM) + LN_EPS); }
#pragma unroll
            for (int r = 0; r < RB; ++r)
#pragma unroll
                for (int j = 0; j < 4; ++j) v[r][j] = v[r][j] * rstd[r] * gv[j] + bv[j];
        }
#pragma unroll
        for (int r = 0; r < RB; ++r) {
            if (FLAGS & RP_WRITE_XF) {
#pragma unroll
                for (int j = 0; j < 4; ++j) ((f32x4*)(XF + (size_t)(m0 + r) * DM))[lane + 64 * j] = v[r][j];
            }
            u32x2* o8 = (u32x2*)(XB + (size_t)(m0 + r) * DM);
#pragma unroll
            for (int j = 0; j < 4; ++j) { u32x2 w; w.x = cvt_pk_bf16(v[r][j].x, v[r][j].y); w.y = cvt_pk_bf16(v[r][j].z, v[r][j].w); o8[lane + 64 * j] = w; }
            if (FLAGS & RP_WRITE_X8) { unsigned* o1 = (unsigned*)(X8 + (size_t)(m0 + r) * DM);
#pragma unroll
                for (int j = 0; j < 4; ++j) o1[lane + 64 * j] = pg8::pack4_fp8(v[r][j].x * S8_X, v[r][j].y * S8_X, v[r][j].z * S8_X, v[r][j].w * S8_X); }
        }
        if (FLAGS & (RP_FORGET | RP_ROUTER)) {
            float d[RB][8];
#pragma unroll
            for (int e = 0; e < 8; ++e) { f32x4 w[4];
#pragma unroll
                for (int j = 0; j < 4; ++j) w[j] = ((const LAS f32x4*)(w8s + e * 1024))[lane + 64 * j];
#pragma unroll
                for (int r = 0; r < RB; ++r) { float a = 0.f;
#pragma unroll
                    for (int j = 0; j < 4; ++j) a += (v[r][j].x * w[j].x + v[r][j].y * w[j].y) + (v[r][j].z * w[j].z + v[r][j].w * w[j].w);
                    d[r][e] = wave_sum_dpp(a); } }
#pragma unroll
            for (int r = 0; r < RB; ++r) {
                const int m = m0 + r;
                if (FLAGS & RP_FORGET) {
                    float lg[8];
#pragma unroll
                    for (int e = 0; e < 8; ++e) { const float z = d[r][e] + bfg[e]; lg[e] = fminf(z, 0.f) - 0.6931471805599453f * __builtin_amdgcn_logf(1.0f + __builtin_amdgcn_exp2f(-fabsf(z) * LOG2E)); }
                    if (lane == 0) { f32x4* dst = (f32x4*)(LOGF + (size_t)m * 8); dst[0] = (f32x4){lg[0], lg[1], lg[2], lg[3]}; dst[1] = (f32x4){lg[4], lg[5], lg[6], lg[7]}; }
                }
                if (FLAGS & RP_ROUTER) {
                    float v0 = -INFINITY, v1 = -INFINITY; int i0 = 0, i1 = 0;
#pragma unroll
                    for (int e = 0; e < 8; ++e) { const float x = d[r][e];
                        if (x > v0) { v1 = v0; i1 = i0; v0 = x; i0 = e; } else if (x > v1) { v1 = x; i1 = e; } }
                    if (lane == 0) {
                        const float ex = __builtin_amdgcn_exp2f((v1 - v0) * LOG2E), inv = 1.f / (1.f + ex);
                        const int r0 = __hip_atomic_fetch_add((LAS int*)(lds + MISC_OFF + 64) + i0, 1, __ATOMIC_RELAXED, __HIP_MEMORY_SCOPE_WORKGROUP), r1 = __hip_atomic_fetch_add((LAS int*)(lds + MISC_OFF + 64) + i1, 1, __ATOMIC_RELAXED, __HIP_MEMORY_SCOPE_WORKGROUP);
                        RE[m] = (unsigned)i0 | ((unsigned)i1 << 8); RR[m] = (unsigned)r0 | ((unsigned)r1 << 16); RG[m] = (f32x2){inv, ex * inv};
                    }
                }
            }
        }
    }
    if (FLAGS & RP_ROUTER) { __syncthreads(); if (tid < 8) CNT[chunk * 8 + tid] = hist[tid]; }
    __syncthreads();
}

__device__ __forceinline__ void fox_scan(LAS unsigned char* lds, int bh, const float* LOGF, float* FL) {
    const int tid = fresh_tid(), lane = tid & 63, wave = __builtin_amdgcn_readfirstlane(tid >> 6);
    LAS float* wtot = (LAS float*)lds;
    const int b = bh >> 3, h = bh & 7;
    float x[8]; float run = 0.f;
#pragma unroll
    for (int i = 0; i < 8; ++i) { run += LOGF[((size_t)b * SEQ + 8 * tid + i) * 8 + h]; x[i] = run; }
    float inc = run;
#pragma unroll
    for (int o = 1; o < 64; o <<= 1) { const float y = __int_as_float(__builtin_amdgcn_ds_bpermute((lane - o) << 2, __float_as_int(inc))); if (lane >= o) inc += y; }
    if (lane == 63) wtot[wave] = inc;
    __syncthreads();
    float pre = inc - run;
#pragma unroll
    for (int w = 0; w < 8; ++w) { const float t = wtot[w]; if (w < wave) pre += t; }
    f32x4 o0 = {(pre + x[0]) * LOG2E, (pre + x[1]) * LOG2E, (pre + x[2]) * LOG2E, (pre + x[3]) * LOG2E}, o1 = {(pre + x[4]) * LOG2E, (pre + x[5]) * LOG2E, (pre + x[6]) * LOG2E, (pre + x[7]) * LOG2E};
    f32x4* dst = (f32x4*)(FL + (size_t)bh * SEQ + 8 * tid); dst[0] = o0; dst[1] = o1;
    __syncthreads();
}

__device__ __forceinline__ void kmean_unit(LAS unsigned char* lds, int c, const bf16_t* Kp  , float* KMEAN) {
    const int tid = fresh_tid(), lane = tid & 63, wave = __builtin_amdgcn_readfirstlane(tid >> 6);
    const int bn = c >> 1, col0 = 512 * (c & 1);
    const bf16_t* p = Kp + ((size_t)bn * 256 + 32 * wave) * 3072 + col0 + 8 * lane;
    float a[8];
#pragma unroll
    for (int j = 0; j < 8; ++j) a[j] = 0.f;
    u32x4 kw[32];
#pragma unroll
    for (int r = 0; r < 32; ++r) kw[r] = *(const u32x4*)(p + (size_t)r * 3072);
    __builtin_amdgcn_sched_barrier(0);
#pragma unroll
    for (int r = 0; r < 32; ++r) { const u32x4 w = kw[r];
        a[0] += bf_lo(w.x); a[1] += bf_hi(w.x); a[2] += bf_lo(w.y); a[3] += bf_hi(w.y); a[4] += bf_lo(w.z); a[5] += bf_hi(w.z); a[6] += bf_lo(w.w); a[7] += bf_hi(w.w); }
    LAS float* red = (LAS float*)lds;
    *(LAS f32x4*)(red + wave * 512 + 8 * lane) = (f32x4){a[0], a[1], a[2], a[3]}; *(LAS f32x4*)(red + wave * 512 + 8 * lane + 4) = (f32x4){a[4], a[5], a[6], a[7]};
    __syncthreads();
    float s = 0.f;
#pragma unroll
    for (int w = 0; w < 8; ++w) s += red[w * 512 + tid];
    KMEAN[(size_t)bn * 1024 + col0 + tid] = s * (1.f / 256.f);
    __syncthreads();
}

__device__ __forceinline__ void moe_sort(LAS unsigned char* lds, int chunk, const int* CNT, const unsigned* RE, const unsigned* RR, const bf16_t* XB, unsigned char* XS8, i32x2* POS, int* PB) {
    const int tid = fresh_tid(), lane = tid & 63, wave = __builtin_amdgcn_readfirstlane(tid >> 6);
    LAS int* tbl = (LAS int*)lds;
    LAS int* tot = (LAS int*)(lds + 8192);
    for (int i = tid; i < 2048; i += 512) tbl[i] = CNT[i];
    __syncthreads();
    { const int e = wave; float t = 0.f, before = 0.f;
#pragma unroll
      for (int j = 0; j < 4; ++j) { const int c = 4 * lane + j; const float v = (float)tbl[c * 8 + e]; t += v; before += (c < chunk) ? v : 0.f; }
      t = wave_sum_dpp(t); before = wave_sum_dpp(before);
      if (lane == 0) { tot[e] = (int)t; tot[8 + e] = (int)before; } }
    __syncthreads();
    if (tid == 0) { int pb = 0; for (int e = 0; e < 8; ++e) { tot[16 + e] = pb * 256 + tot[8 + e]; pb += (tot[e] + 255) >> 8; tot[24 + e] = pb; } if (chunk == 0) PB[8] = pb; }
    __syncthreads();
    if (chunk == 0 && tid < tot[31]) { int e = 0;
#pragma unroll
        for (int k = 0; k < 7; ++k) e += (tid >= tot[24 + k]) ? 1 : 0;
        PB[16 + tid] = e; }
#pragma unroll 1
    for (int it = 0; it < 4; ++it) {
        const int m0 = chunk * 128 + wave * 16 + it * 4;
        unsigned e[4], r[4]; u32x2 xw[4][4];
#pragma unroll
        for (int q = 0; q < 4; ++q) { e[q] = RE[m0 + q]; r[q] = RR[m0 + q];
#pragma unroll
            for (int j = 0; j < 4; ++j) xw[q][j] = ((const u32x2*)(XB + (size_t)(m0 + q) * DM))[lane + 64 * j]; }
#pragma unroll
        for (int q = 0; q < 4; ++q) {
            const int p0 = tot[16 + (e[q] & 0xff)] + (int)(r[q] & 0xffff), p1 = tot[16 + (e[q] >> 8)] + (int)(r[q] >> 16);
            unsigned* d0 = (unsigned*)(XS8 + (size_t)p0 * DM); unsigned* d1 = (unsigned*)(XS8 + (size_t)p1 * DM);
#pragma unroll
            for (int j = 0; j < 4; ++j) { const u32x2 x = xw[q][j]; const unsigned w = pg8::pack4_fp8(bf_lo(x.x) * S8_X, bf_hi(x.x) * S8_X, bf_lo(x.y) * S8_X, bf_hi(x.y) * S8_X); d0[lane + 64 * j] = w; d1[lane + 64 * j] = w; }
            if (lane == 0) POS[m0 + q] = (i32x2){p0, p1};
        }
    }
    __syncthreads();
}

constexpr float AT_THR = 6.0f;
constexpr float AT_PRUNE = 48.0f;
__device__ __forceinline__ float half_sum(float v) { auto r = __builtin_amdgcn_permlane32_swap(__float_as_uint(v), __float_as_uint(v), false, false); return __uint_as_float(r[0]) + __uint_as_float(r[1]); }
__device__ __forceinline__ float half_max(float v) { auto r = __builtin_amdgcn_permlane32_swap(__float_as_uint(v), __float_as_uint(v), false, false); return fmaxf(__uint_as_float(r[0]), __uint_as_float(r[1])); }
__device__ __forceinline__ int crow(int r, int hi) { return (r & 3) + 8 * (r >> 2) + 4 * hi; }
__device__ __forceinline__ s16x4 vtr(const LAS unsigned char* p) { return __builtin_bit_cast(s16x4, __builtin_amdgcn_ds_read_tr16_b64_v4i16((LAS s16x4*)p)); }

constexpr int PL_PITCH = 272;
template <int W>
__device__ __forceinline__ void pool_mix(LAS unsigned char* lds, int tid, const bf16_t* up, int tseq0) {
    const int cp = tid & 63, i0 = 32 * (tid >> 6);
    const bf16_t* src = up + 2 * cp;
    unsigned uu[32 + W - 1];
#pragma unroll
    for (int k = 0; k < 32 + W - 1; ++k) { const int i = i0 - (W - 1) + k; uu[k] = (tseq0 + i >= 0) ? *(const unsigned*)(src + (long)i * 2048) : 0u; }
    float s0 = 0.f, s1 = 0.f;
#pragma unroll
    for (int k = 0; k < W - 1; ++k) { s0 += bf_lo(uu[k]); s1 += bf_hi(uu[k]); }
#pragma unroll
    for (int r = 0; r < 32; ++r) { const unsigned x = uu[r + W - 1]; const float a = bf_lo(x), b = bf_hi(x); s0 += a; s1 += b;
        const int t = tseq0 + i0 + r; const float icnt = __builtin_amdgcn_rcpf((float)((t + 1 < W) ? (t + 1) : W));
        *(LAS unsigned*)(lds + (i0 + r) * PL_PITCH + cp * 4) = cvt_pk_bf16(s0 * icnt - a, s1 * icnt - b);
        s0 -= bf_lo(uu[r]); s1 -= bf_hi(uu[r]); }
}
__device__ __forceinline__ void pool_unit(LAS unsigned char* lds, int pm, int g, const bf16_t* HC  , const bf16_t* WP  , bf16_t* CAT  ) {
    const int tid = fresh_tid(), lane = tid & 63, wv = __builtin_amdgcn_readfirstlane(tid >> 6), fr = lane & 15, fq = lane >> 4;
    const int row0 = pm * 256, tseq0 = row0 & (SEQ - 1);
    { const bf16_t* up = HC + (size_t)row0 * 2048 + 1536 + 128 * g;
      if (g == 0) pool_mix<2>(lds, tid, up, tseq0); else if (g == 1) pool_mix<4>(lds, tid, up, tseq0); else if (g == 2) pool_mix<8>(lds, tid, up, tseq0); else pool_mix<16>(lds, tid, up, tseq0); }
    const bf16_t* wp = WP + (size_t)g * 16384;
    bf16x8 bw[4][8];
#pragma unroll
    for (int ks = 0; ks < 4; ++ks)
#pragma unroll
        for (int n = 0; n < 8; ++n) bw[ks][n] = *(const bf16x8*)(wp + (16 * n + fr) * 128 + 32 * ks + 8 * fq);
    __builtin_amdgcn_sched_barrier(0);
    __syncthreads();
    f32x4 acc[2][8];
#pragma unroll
    for (int m = 0; m < 2; ++m)
#pragma unroll
        for (int n = 0; n < 8; ++n) acc[m][n] = (f32x4){0.f, 0.f, 0.f, 0.f};
#pragma unroll
    for (int ks = 0; ks < 4; ++ks) {
        bf16x8 a[2];
#pragma unroll
        for (int m = 0; m < 2; ++m) a[m] = *(const LAS bf16x8*)(lds + (32 * wv + 16 * m + fr) * PL_PITCH + (32 * ks + 8 * fq) * 2);
#pragma unroll
        for (int n = 0; n < 8; ++n) {
            const bf16x8 bfrag = bw[ks][n];
#pragma unroll
            for (int m = 0; m < 2; ++m) acc[m][n] = __builtin_amdgcn_mfma_f32_16x16x32_bf16(bfrag, a[m], acc[m][n], 0, 0, 0); }
    }
#pragma unroll
    for (int m = 0; m < 2; ++m) { bf16_t* orow = CAT + (size_t)(row0 + 32 * wv + 16 * m + fr) * 1024 + 512 + 128 * g + 4 * fq;
#pragma unroll
        for (int n = 0; n < 8; ++n) { u32x2 o; o.x = cvt_pk_bf16(acc[m][n][0], acc[m][n][1]); o.y = cvt_pk_bf16(acc[m][n][2], acc[m][n][3]); *(u32x2*)(orow + 16 * n) = o; } }
    __syncthreads();
}

constexpr int MB_CAPR = 5888;
constexpr int MB_KB = 0, MB_VB = 32768, MB_WS = 65536, MB_KM = 73728, MB_CNT = 77824, MB_LIST = 78080, MB_PK = 90112, MB_END = MB_PK + 2304 * 3 * 4;
static_assert(MB_LIST + MB_CAPR * 2 <= MB_PK && MB_END <= RING_BYTES, "MoBA LDS map");

__device__ __forceinline__ void moba_issue_block(u32x4 (&kr)[4], u32x4 (&vr)[4], int lane, int wid, const bf16_t* Kblk, const bf16_t* Vblk, int pitch) {
    const bf16_t* ksrc = Kblk + (size_t)lane * pitch + wid * 8;
    const bf16_t* vsrc = Vblk + (size_t)(16 * (wid & 3) + (lane >> 2)) * pitch + (wid >> 2) * 32 + (lane & 3) * 8;
#pragma unroll
    for (int j = 0; j < 4; ++j) { kr[j] = *(const u32x4*)(ksrc + (size_t)j * 64 * pitch); vr[j] = *(const u32x4*)(vsrc + (size_t)j * 64 * pitch); }
}
__device__ __forceinline__ void moba_commit_block(LAS unsigned char* lds, const u32x4 (&kr)[4], const u32x4 (&vr)[4], int lane, int wid) {
    const int stoff = wid * 1024 + lane * 16;
#pragma unroll
    for (int j = 0; j < 4; ++j) { *(LAS u32x4*)(lds + MB_KB + j * 8192 + stoff) = kr[j]; *(LAS u32x4*)(lds + MB_VB + j * 8192 + stoff) = vr[j]; }
}
template <bool CAUSAL>
__device__ __forceinline__ void moba_block(LAS unsigned char* lds, int lane, int wid, int r32, int hi, const bf16x8 (&qr)[4], int qrel, int qmax, float& mhat, float& lsum, f32x16& o0, f32x16& o1) {
    LAS float* wsf = (LAS float*)(lds + MB_WS) + wid * 256;
    const int kfo = hi * 1024 + r32 * 16;
    const int vfo = ((lane >> 4) & 1) * 32 + (lane & 3) * 8 + (4 * hi + ((lane & 15) >> 2)) * 64;
#pragma unroll 1
    for (int t = 0; t < 4; ++t) {
        if (CAUSAL) { if (64 * t > qmax) break; }
        {
            const LAS unsigned char* kb_ = lds + MB_KB + t * 8192 + kfo;
            f32x16 p0 = {}, p1 = {};
bf16x8 kf[8];
#pragma unroll
            for (int d0 = 0; d0 < 4; ++d0) { kf[2 * d0] = *(const LAS bf16x8*)(kb_ + d0 * 2048); kf[2 * d0 + 1] = *(const LAS bf16x8*)(kb_ + d0 * 2048 + 512); }
            __builtin_amdgcn_sched_barrier(0);
#pragma unroll
            for (int d0 = 0; d0 < 4; ++d0) { p0 = __builtin_amdgcn_mfma_f32_32x32x16_bf16(kf[2 * d0], qr[d0], p0, 0, 0, 0); p1 = __builtin_amdgcn_mfma_f32_32x32x16_bf16(kf[2 * d0 + 1], qr[d0], p1, 0, 0, 0); }
            s16x4 vlo[8], vhi[8];
            { const LAS unsigned char* vq_ = (lds + MB_VB + t * 8192 + vfo);
#pragma unroll
              for (int i = 0; i < 8; ++i) { vlo[i] = vtr(vq_ + (i & 1) * 4096 + (i >> 1) * 1024); vhi[i] = vtr(vq_ + (i & 1) * 4096 + (i >> 1) * 1024 + 512); } }
            __builtin_amdgcn_sched_barrier(0);
#pragma unroll
            for (int r = 0; r < 16; ++r) { p0[r] -= mhat; p1[r] -= mhat; }
            if (CAUSAL) { const int kbase = 64 * t + 4 * hi;
#pragma unroll
                for (int r = 0; r < 16; ++r) { const int kv = kbase + (r & 3) + 8 * (r >> 2); if (kv > qrel) p0[r] = -INFINITY; if (kv + 32 > qrel) p1[r] = -INFINITY; } }
#define MX3(a_, b_, c_) __builtin_fmaxf(__builtin_fmaxf((a_), (b_)), (c_))
            float ra = MX3(p0[0], p0[1], p1[0]), rb = MX3(p0[2], p0[3], p1[1]); ra = MX3(ra, p1[2], p1[3]);
#pragma unroll
            for (int r = 4; r < 16; r += 4) { ra = MX3(ra, p0[r], p0[r + 1]); rb = MX3(rb, p0[r + 2], p0[r + 3]); ra = MX3(ra, p1[r], p1[r + 1]); rb = MX3(rb, p1[r + 2], p1[r + 3]); }
#undef MX3
            const float rm = half_max(fmaxf(ra, rb));
            const bool mv = rm > AT_THR;
            if (__any(mv)) {
                const float dl = mv ? rm : 0.f, al = __builtin_amdgcn_exp2f(-dl); mhat += dl; lsum *= al;
#pragma unroll
                for (int r = 0; r < 16; ++r) { p0[r] -= dl; p1[r] -= dl; }
                if (hi == 0) wsf[r32] = al;
#pragma unroll
                for (int g = 0; g < 4; ++g) { const f32x4 a4 = *(const LAS f32x4*)(wsf + 8 * g + 4 * hi);
                    o0[4 * g + 0] *= a4.x; o0[4 * g + 1] *= a4.y; o0[4 * g + 2] *= a4.z; o0[4 * g + 3] *= a4.w; o1[4 * g + 0] *= a4.x; o1[4 * g + 1] *= a4.y; o1[4 * g + 2] *= a4.z; o1[4 * g + 3] *= a4.w; }
            }
            float ps = 0.f;
#pragma unroll
            for (int r = 0; r < 16; ++r) { p0[r] = __builtin_amdgcn_exp2f(p0[r]); p1[r] = __builtin_amdgcn_exp2f(p1[r]); ps += p0[r] + p1[r]; }
            lsum += ps;
            u32x4 pw0, pw1, pw2, pw3;
            pw0.x = cvt_pk_bf16(p0[0], p0[1]); pw0.y = cvt_pk_bf16(p0[2], p0[3]); pw0.z = cvt_pk_bf16(p0[4], p0[5]); pw0.w = cvt_pk_bf16(p0[6], p0[7]);
            pw1.x = cvt_pk_bf16(p0[8], p0[9]); pw1.y = cvt_pk_bf16(p0[10], p0[11]); pw1.z = cvt_pk_bf16(p0[12], p0[13]); pw1.w = cvt_pk_bf16(p0[14], p0[15]);
            pw2.x = cvt_pk_bf16(p1[0], p1[1]); pw2.y = cvt_pk_bf16(p1[2], p1[3]); pw2.z = cvt_pk_bf16(p1[4], p1[5]); pw2.w = cvt_pk_bf16(p1[6], p1[7]);
            pw3.x = cvt_pk_bf16(p1[8], p1[9]); pw3.y = cvt_pk_bf16(p1[10], p1[11]); pw3.z = cvt_pk_bf16(p1[12], p1[13]); pw3.w = cvt_pk_bf16(p1[14], p1[15]);
            __builtin_amdgcn_sched_barrier(0);
#define PV_STEP(OACC, I, PW) do { const bf16x8 vf_ = {vlo[I][0], vlo[I][1], vlo[I][2], vlo[I][3], vhi[I][0], vhi[I][1], vhi[I][2], vhi[I][3]}; \
                OACC = __builtin_amdgcn_mfma_f32_32x32x16_bf16(__builtin_bit_cast(bf16x8, PW), vf_, OACC, 0, 0, 0); } while (0)
            PV_STEP(o0, 0, pw0); PV_STEP(o1, 1, pw0); PV_STEP(o0, 2, pw1); PV_STEP(o1, 3, pw1);
            PV_STEP(o0, 4, pw2); PV_STEP(o1, 5, pw2); PV_STEP(o0, 6, pw3); PV_STEP(o1, 7, pw3);
#undef PV_STEP
        }
    }
}

__device__ __forceinline__ void moba_part(LAS unsigned char* lds, int wg, const bf16_t* Qp, const bf16_t* Kp, const bf16_t* Vp, int pitch, bf16_t* Op, int opitch,
                                          const float* KMEAN, bf16_t* PART, f32x2* ML) {
    const int tid = fresh_tid(), lane = tid & 63, r32 = lane & 31, hi = lane >> 5; const int wid = __builtin_amdgcn_readfirstlane(tid >> 6);
    const int bh = wg >> 1, part = wg & 1, b = bh >> 4, h = bh & 15;
    const int qb_lo = part ? 9 : 0, qb_hi = part ? 16 : 9, nq = (qb_hi - qb_lo) * 256;
    const size_t rowbase = (size_t)b * SEQ; const size_t pbase = (size_t)wg * MB_CAPR;
    LAS float* km = (LAS float*)(lds + MB_KM);
    LAS int* cnt = (LAS int*)(lds + MB_CNT); LAS int* off = cnt + 16;
    LAS unsigned short* LIST = (LAS unsigned short*)(lds + MB_LIST);
    LAS unsigned* PK = (LAS unsigned*)(lds + MB_PK);
    LAS float* wsf = (LAS float*)(lds + MB_WS) + wid * 256;
    bf16_t* POWN = (bf16_t*)(ML + (size_t)4 * 1024 * 1024) + (size_t)wg * 2304 * 64;
    f32x2* MLO = ML + (size_t)256 * MB_CAPR + (size_t)wg * 2304;
    for (int i = tid; i < 16 * 64; i += 512) km[i] = KMEAN[((size_t)b * 16 + (i >> 6)) * 1024 + h * 64 + (i & 63)];
    if (tid < 16) cnt[tid] = 0;
    __syncthreads();
#pragma unroll 1
    for (int qb = qb_lo; qb < qb_hi; ++qb) {
        const bf16_t* Qw = Qp + (rowbase + qb * 256 + wid * 32 + r32) * pitch + h * 64;
        bf16x8 qr[4];
#pragma unroll
        for (int d0 = 0; d0 < 4; ++d0) qr[d0] = *(const bf16x8*)(Qw + d0 * 16 + hi * 8);
        float qf[32];
#pragma unroll
        for (int d0 = 0; d0 < 4; ++d0)
#pragma unroll
            for (int j = 0; j < 8; ++j) qf[d0 * 8 + j] = __uint_as_float((unsigned)(unsigned short)qr[d0][j] << 16);
        float v1 = -INFINITY, v2 = -INFINITY, v3 = -INFINITY; int i1 = 0, i2 = 1, i3 = 2;
        if (qb > 3) {
            for (int n = 0; n < qb; ++n) {
                float part_ = 0.f;
#pragma unroll
                for (int d0 = 0; d0 < 4; ++d0) { const f32x4 ka = *(const LAS f32x4*)(km + n * 64 + d0 * 16 + hi * 8), kb = *(const LAS f32x4*)(km + n * 64 + d0 * 16 + hi * 8 + 4);
                    part_ += (qf[d0 * 8 + 0] * ka.x + qf[d0 * 8 + 1] * ka.y) + (qf[d0 * 8 + 2] * ka.z + qf[d0 * 8 + 3] * ka.w) + (qf[d0 * 8 + 4] * kb.x + qf[d0 * 8 + 5] * kb.y) + (qf[d0 * 8 + 6] * kb.z + qf[d0 * 8 + 7] * kb.w); }
                const float g = half_sum(part_);
                if (g > v1) { v3 = v2; i3 = i2; v2 = v1; i2 = i1; v1 = g; i1 = n; } else if (g > v2) { v3 = v2; i3 = i2; v2 = g; i2 = n; } else if (g > v3) { v3 = g; i3 = n; }
            }
        }
        const int npick = qb < 3 ? qb : 3;
        if (hi == 0) { const int tl = (qb - qb_lo) * 256 + wid * 32 + r32;
            unsigned e0 = 0xffffffffu, e1 = 0xffffffffu, e2 = 0xffffffffu;
            if (npick > 0) e0 = ((unsigned)i1 << 16) | (unsigned)__hip_atomic_fetch_add(cnt + i1, 1, __ATOMIC_RELAXED, __HIP_MEMORY_SCOPE_WORKGROUP);
            if (npick > 1) e1 = ((unsigned)i2 << 16) | (unsigned)__hip_atomic_fetch_add(cnt + i2, 1, __ATOMIC_RELAXED, __HIP_MEMORY_SCOPE_WORKGROUP);
            if (npick > 2) e2 = ((unsigned)i3 << 16) | (unsigned)__hip_atomic_fetch_add(cnt + i3, 1, __ATOMIC_RELAXED, __HIP_MEMORY_SCOPE_WORKGROUP);
            PK[tl * 3 + 0] = e0; PK[tl * 3 + 1] = e1; PK[tl * 3 + 2] = e2; }
    }
    __syncthreads();
    if (tid == 0) { int run = 0; for (int n = 0; n < 16; ++n) { off[n] = run; run += (cnt[n] + 31) & ~31; } off[16] = run; }
    __syncthreads();
    for (int tl = tid; tl < nq; tl += 512) {
#pragma unroll
        for (int s = 0; s < 3; ++s) { const unsigned e = PK[tl * 3 + s];
            if (e != 0xffffffffu) { const int row = off[e >> 16] + (int)(e & 0xffffu); LIST[row] = (unsigned short)(qb_lo * 256 + tl); PK[tl * 3 + s] = (unsigned)row; } }
    }
    if (tid < 16) { for (int r = off[tid] + cnt[tid]; r < off[tid + 1]; ++r) LIST[r] = (unsigned short)(qb_lo * 256); }
    __syncthreads();
#define MB_STORE_PARTIAL(DST, MLP) do { const float ltot_ = half_sum(lsum); \
        if (hi == 0) { wsf[r32] = 1.0f / ltot_; (MLP)[r32] = (f32x2){mhat, ltot_}; } \
        _Pragma("unroll") for (int g = 0; g < 4; ++g) { const f32x4 a4 = *(const LAS f32x4*)(wsf + 8 * g + 4 * hi); \
            _Pragma("unroll") for (int j = 0; j < 4; ++j) { const int r = 4 * g + j; const float inv_ = (j == 0) ? a4.x : (j == 1) ? a4.y : (j == 2) ? a4.z : a4.w; \
                ((unsigned*)(DST))[(size_t)crow(r, hi) * 32 + r32] = cvt_pk_bf16(o0[r] * inv_, o1[r] * inv_); } } } while (0)
    {
        u32x4 kr[4], vr[4];
#define MB_WORK(n_) ((off[(n_) + 1] > off[(n_)]) || ((n_) >= qb_lo && (n_) < qb_hi))
        int n = 0; while (n < 16 && !MB_WORK(n)) ++n;
        n = __builtin_amdgcn_readfirstlane(n);
        if (n < 16) moba_issue_block(kr, vr, lane, wid, Kp + (rowbase + n * 256) * pitch + h * 64, Vp + (rowbase + n * 256) * pitch + h * 64, pitch);
#pragma unroll 1
        while (n < 16) {
            const int o_n = __builtin_amdgcn_readfirstlane(off[n]), len = __builtin_amdgcn_readfirstlane(off[n + 1]) - o_n;
            const int G = len >> 5, T = G + ((n >= qb_lo && n < qb_hi) ? 8 : 0);
#define MB_TASK_ROW(j_) (((j_) < G) ? (int)LIST[o_n + 32 * (j_) + r32] : (n * 256 + (7 - ((j_) - G)) * 32 + r32))
            bf16x8 qr[4];
            if (wid < T) { const int t = MB_TASK_ROW(wid); const bf16_t* Qw = Qp + (rowbase + t) * pitch + h * 64;
#pragma unroll
                for (int d0 = 0; d0 < 4; ++d0) qr[d0] = *(const bf16x8*)(Qw + d0 * 16 + hi * 8); }
            __syncthreads();
            moba_commit_block(lds, kr, vr, lane, wid);
            __syncthreads();
            int nn = n + 1; while (nn < 16 && !MB_WORK(nn)) ++nn;
            nn = __builtin_amdgcn_readfirstlane(nn);
            if (nn < 16) moba_issue_block(kr, vr, lane, wid, Kp + (rowbase + nn * 256) * pitch + h * 64, Vp + (rowbase + nn * 256) * pitch + h * 64, pitch);
#pragma unroll 1
            for (int j = wid; j < T; j += 8) {
                bf16x8 qn[4];
                if (j + 8 < T) { const int t = MB_TASK_ROW(j + 8); const bf16_t* Qw = Qp + (rowbase + t) * pitch + h * 64;
#pragma unroll
                    for (int d0 = 0; d0 < 4; ++d0) qn[d0] = *(const bf16x8*)(Qw + d0 * 16 + hi * 8); }
                float mhat = 0.f, lsum = 0.f; f32x16 o0 = {}, o1 = {};
                if (j < G) {
                    moba_block<false>(lds, lane, wid, r32, hi, qr, 0, 0, mhat, lsum, o0, o1);
                    bf16_t* pdst = PART + (pbase + o_n + 32 * j) * 64; f32x2* mdst = ML + pbase + o_n + 32 * j;
                    MB_STORE_PARTIAL(pdst, mdst);
                } else { const int og = 7 - (j - G);
                    moba_block<true>(lds, lane, wid, r32, hi, qr, og * 32 + r32, og * 32 + 31, mhat, lsum, o0, o1);
                    bf16_t* pdst = POWN + ((size_t)(n - qb_lo) * 256 + og * 32) * 64; f32x2* mdst = MLO + (n - qb_lo) * 256 + og * 32;
                    MB_STORE_PARTIAL(pdst, mdst);
                }
                if (j + 8 < T) {
#pragma unroll
                    for (int d0 = 0; d0 < 4; ++d0) qr[d0] = qn[d0]; }
            }
            n = nn;
        }
#undef MB_TASK_ROW
#undef MB_WORK
    }
#undef MB_STORE_PARTIAL
    __syncthreads();
#pragma unroll 2
    for (int i = tid; i < nq * 8; i += 512) {
        const int tl = i >> 3, c = i & 7;
        const unsigned r1 = PK[tl * 3 + 0], r2 = PK[tl * 3 + 1], r3 = PK[tl * 3 + 2];
        const f32x2 so = MLO[tl];
        f32x2 s1 = {-1e30f, 0.f}, s2 = {-1e30f, 0.f}, s3 = {-1e30f, 0.f};
        if (r1 != 0xffffffffu) s1 = ML[pbase + r1]; if (r2 != 0xffffffffu) s2 = ML[pbase + r2]; if (r3 != 0xffffffffu) s3 = ML[pbase + r3];
        const float M = fmaxf(fmaxf(so.x, s1.x), fmaxf(s2.x, s3.x));
        const float wo = __builtin_amdgcn_exp2f(so.x - M) * so.y, w1 = __builtin_amdgcn_exp2f(s1.x - M) * s1.y, w2 = __builtin_amdgcn_exp2f(s2.x - M) * s2.y, w3 = __builtin_amdgcn_exp2f(s3.x - M) * s3.y;
        const float inv = 1.0f / (wo + w1 + w2 + w3);
        const u32x4 zero4 = {0u, 0u, 0u, 0u};
        const u32x4 xo = *(const u32x4*)(POWN + (size_t)tl * 64 + c * 8);
        const u32x4 x1 = (r1 != 0xffffffffu) ? *(const u32x4*)(PART + (pbase + r1) * 64 + c * 8) : zero4;
        const u32x4 x2 = (r2 != 0xffffffffu) ? *(const u32x4*)(PART + (pbase + r2) * 64 + c * 8) : zero4;
        const u32x4 x3 = (r3 != 0xffffffffu) ? *(const u32x4*)(PART + (pbase + r3) * 64 + c * 8) : zero4;
        const float fo = wo * inv, f1 = w1 * inv, f2 = w2 * inv, f3 = w3 * inv;
#define MB_LO(k) (fo * bf_lo(xo[k]) + (f1 * bf_lo(x1[k]) + f2 * bf_lo(x2[k]) + f3 * bf_lo(x3[k])))
#define MB_HI(k) (fo * bf_hi(xo[k]) + (f1 * bf_hi(x1[k]) + f2 * bf_hi(x2[k]) + f3 * bf_hi(x3[k])))
        bf16_t* orow = Op + (rowbase + qb_lo * 256 + tl) * opitch + h * 64 + c * 4;
        *(u32x2*)orow = (u32x2){cvt_pk_bf16(MB_LO(0), MB_LO(1)), cvt_pk_bf16(MB_LO(2), MB_LO(3))};
        *(u32x2*)(orow + 32) = (u32x2){cvt_pk_bf16(MB_HI(0), MB_HI(1)), cvt_pk_bf16(MB_HI(2), MB_HI(3))};
#undef MB_LO
#undef MB_HI
    }
    __syncthreads();
}

constexpr int FX_FB = 65536 + 8192;
__device__ __forceinline__ void fox_unit(LAS unsigned char* lds, const bf16_t* Qp, const bf16_t* Kp, const bf16_t* Vp, int pitch, bf16_t* Op, int opitch, int b, int h, int qb, const float* FLbh) {
    const int tid = fresh_tid(), lane = tid & 63, r32 = lane & 31, hi = lane >> 5; const int wid = __builtin_amdgcn_readfirstlane(tid >> 6);
    const size_t rowbase = (size_t)b * SEQ; const int q0 = qb * 256;
    const bf16_t* Qw = Qp + (rowbase + q0 + wid * 32 + r32) * pitch + h * 64;
    bf16x8 qr[4];
#pragma unroll
    for (int d0 = 0; d0 < 4; ++d0) qr[d0] = *(const bf16x8*)(Qw + d0 * 16 + hi * 8);
    const int NT = 4 * (qb + 1);
    const float flq0 = FLbh[q0], flw0 = FLbh[q0 + wid * 32];
    int t0u, t0w;
    { const bool live = lane < NT - 4; const float fe = live ? FLbh[64 * lane + 63] : 0.f;
      t0u = __builtin_popcountll(__ballot(live && (flq0 - fe < -AT_PRUNE))); t0w = __builtin_popcountll(__ballot(live && (flw0 - fe < -AT_PRUNE))); }
    t0u = __builtin_amdgcn_readfirstlane(t0u); t0w = __builtin_amdgcn_readfirstlane(t0w);
    const int kb0 = t0u >> 2;
    float mhat = -1e30f, lsum = 0.f; f32x16 o0 = {}, o1 = {};
    LAS float* wsf = (LAS float*)(lds + MB_WS) + wid * 256;
    LAS float* fbl = (LAS float*)(lds + FX_FB);
    const int kfo = hi * 1024 + r32 * 16;
    const int vfo = ((lane >> 4) & 1) * 32 + (lane & 3) * 8 + (4 * hi + ((lane & 15) >> 2)) * 64;
    const int qrel = wid * 32 + r32;
    const bf16_t* Kh = Kp + rowbase * pitch + h * 64; const bf16_t* Vh = Vp + rowbase * pitch + h * 64;
    u32x4 kr[4], vr[4]; float fr_ = 0.f;
    moba_issue_block(kr, vr, lane, wid, Kh + (size_t)kb0 * 256 * pitch, Vh + (size_t)kb0 * 256 * pitch, pitch);
    if (tid < 256) fr_ = flq0 - FLbh[kb0 * 256 + tid];
#pragma unroll 1
    for (int kb = kb0; kb <= qb; ++kb) {
        __syncthreads();
        moba_commit_block(lds, kr, vr, lane, wid);
        if (tid < 256) fbl[tid] = fr_;
        __syncthreads();
        if (kb < qb) { moba_issue_block(kr, vr, lane, wid, Kh + (size_t)(kb + 1) * 256 * pitch, Vh + (size_t)(kb + 1) * 256 * pitch, pitch); if (tid < 256) fr_ = flq0 - FLbh[(kb + 1) * 256 + tid]; }
        const bool diag = (kb == qb);
#pragma unroll 1
        for (int t = 0; t < 4; ++t) {
            if (kb * 4 + t < t0w) continue;
            if (diag && 64 * t > wid * 32 + 31) break;
            const LAS unsigned char* kb_ = lds + MB_KB + t * 8192 + kfo;
            f32x16 p0 = {}, p1 = {};
            bf16x8 kf[8];
#pragma unroll
            for (int d0 = 0; d0 < 4; ++d0) { kf[2 * d0] = *(const LAS bf16x8*)(kb_ + d0 * 2048); kf[2 * d0 + 1] = *(const LAS bf16x8*)(kb_ + d0 * 2048 + 512); }
            __builtin_amdgcn_sched_barrier(0);
#pragma unroll
            for (int d0 = 0; d0 < 4; ++d0) { p0 = __builtin_amdgcn_mfma_f32_32x32x16_bf16(kf[2 * d0], qr[d0], p0, 0, 0, 0); p1 = __builtin_amdgcn_mfma_f32_32x32x16_bf16(kf[2 * d0 + 1], qr[d0], p1, 0, 0, 0); }
            s16x4 vlo[8], vhi[8];
            { const LAS unsigned char* vq_ = lds + MB_VB + t * 8192 + vfo;
#pragma unroll
              for (int i = 0; i < 8; ++i) { vlo[i] = vtr(vq_ + (i & 1) * 4096 + (i >> 1) * 1024); vhi[i] = vtr(vq_ + (i & 1) * 4096 + (i >> 1) * 1024 + 512); } }
            __builtin_amdgcn_sched_barrier(0);
            { const LAS float* fb = fbl + 64 * t;
#pragma unroll
              for (int g = 0; g < 4; ++g) { const f32x4 fa = *(const LAS f32x4*)(fb + 8 * g + 4 * hi), fc = *(const LAS f32x4*)(fb + 32 + 8 * g + 4 * hi);
                  p0[4 * g + 0] += fa.x; p0[4 * g + 1] += fa.y; p0[4 * g + 2] += fa.z; p0[4 * g + 3] += fa.w; p1[4 * g + 0] += fc.x; p1[4 * g + 1] += fc.y; p1[4 * g + 2] += fc.z; p1[4 * g + 3] += fc.w; } }
            if (diag) { const int kbase = 64 * t + 4 * hi;
#pragma unroll
                for (int r = 0; r < 16; ++r) { const int kv = kbase + (r & 3) + 8 * (r >> 2); if (kv > qrel) p0[r] = -INFINITY; if (kv + 32 > qrel) p1[r] = -INFINITY; } }
            float rm = fmaxf(p0[0], p1[0]);
#pragma unroll
            for (int r = 1; r < 16; ++r) rm = fmaxf(rm, fmaxf(p0[r], p1[r]));
            rm = half_max(rm);
            if (__any(rm > mhat + AT_THR)) {
                const float mnew = fmaxf(mhat, rm), al = __builtin_amdgcn_exp2f(mhat - mnew); mhat = mnew; lsum *= al;
                if (hi == 0) wsf[r32] = al;
#pragma unroll
                for (int g = 0; g < 4; ++g) { const f32x4 a4 = *(const LAS f32x4*)(wsf + 8 * g + 4 * hi);
                    o0[4 * g + 0] *= a4.x; o0[4 * g + 1] *= a4.y; o0[4 * g + 2] *= a4.z; o0[4 * g + 3] *= a4.w; o1[4 * g + 0] *= a4.x; o1[4 * g + 1] *= a4.y; o1[4 * g + 2] *= a4.z; o1[4 * g + 3] *= a4.w; }
            }
            float ps = 0.f;
#pragma unroll
            for (int r = 0; r < 16; ++r) { p0[r] = __builtin_amdgcn_exp2f(p0[r] - mhat); p1[r] = __builtin_amdgcn_exp2f(p1[r] - mhat); ps += p0[r] + p1[r]; }
            lsum += ps;
            u32x4 pw0, pw1, pw2, pw3;
            pw0.x = cvt_pk_bf16(p0[0], p0[1]); pw0.y = cvt_pk_bf16(p0[2], p0[3]); pw0.z = cvt_pk_bf16(p0[4], p0[5]); pw0.w = cvt_pk_bf16(p0[6], p0[7]);
            pw1.x = cvt_pk_bf16(p0[8], p0[9]); pw1.y = cvt_pk_bf16(p0[10], p0[11]); pw1.z = cvt_pk_bf16(p0[12], p0[13]); pw1.w = cvt_pk_bf16(p0[14], p0[15]);
            pw2.x = cvt_pk_bf16(p1[0], p1[1]); pw2.y = cvt_pk_bf16(p1[2], p1[3]); pw2.z = cvt_pk_bf16(p1[4], p1[5]); pw2.w = cvt_pk_bf16(p1[6], p1[7]);
            pw3.x = cvt_pk_bf16(p1[8], p1[9]); pw3.y = cvt_pk_bf16(p1[10], p1[11]); pw3.z = cvt_pk_bf16(p1[12], p1[13]); pw3.w = cvt_pk_bf16(p1[14], p1[15]);
            __builtin_amdgcn_sched_barrier(0);
#define PV_STEP(OACC, I, PW) do { const bf16x8 vf_ = {vlo[I][0], vlo[I][1], vlo[I][2], vlo[I][3], vhi[I][0], vhi[I][1], vhi[I][2], vhi[I][3]}; \
                OACC = __builtin_amdgcn_mfma_f32_32x32x16_bf16(__builtin_bit_cast(bf16x8, PW), vf_, OACC, 0, 0, 0); } while (0)
            PV_STEP(o0, 0, pw0); PV_STEP(o1, 1, pw0); PV_STEP(o0, 2, pw1); PV_STEP(o1, 3, pw1);
            PV_STEP(o0, 4, pw2); PV_STEP(o1, 5, pw2); PV_STEP(o0, 6, pw3); PV_STEP(o1, 7, pw3);
#undef PV_STEP
        }
    }
    const float ltot = half_sum(lsum);
    if (hi == 0) wsf[r32] = 1.0f / ltot;
    bf16_t* Ow = Op + (rowbase + q0 + wid * 32) * opitch + h * 64 + r32;
#pragma unroll
    for (int g = 0; g < 4; ++g) { const f32x4 a4 = *(const LAS f32x4*)(wsf + 8 * g + 4 * hi);
#pragma unroll
        for (int j = 0; j < 4; ++j) { const int r = 4 * g + j; const float inv = (j == 0) ? a4.x : (j == 1) ? a4.y : (j == 2) ? a4.z : a4.w;
            bf16_t* orow = Ow + (size_t)crow(r, hi) * opitch;
            orow[0] = (bf16_t)(cvt_pk_bf16(o0[r] * inv, 0.f) & 0xffffu); orow[32] = (bf16_t)(cvt_pk_bf16(o1[r] * inv, 0.f) & 0xffffu); } }
    __syncthreads();
}

#ifndef E4F8_PAIR
#define E4F8_PAIR 1
#endif

struct Args { const float* in[19]; float* out; unsigned char* ws; };


typedef __attribute__((address_space(4))) const unsigned long long kq_t;
__device__ __forceinline__ kq_t* kargs() { kq_t* p = (kq_t*)__builtin_amdgcn_kernarg_segment_ptr(); asm volatile("" : "+s"(p)); return p; }
#define INP(k) ((const float*)(GAS const float*)kargs()[(k)])
#define OUTP ((float*)(GAS float*)kargs()[19])
#define WSP ((unsigned char*)(GAS unsigned char*)kargs()[20])
__device__ __forceinline__ void convert_even(int i, unsigned char* W, LAS unsigned char* lds, int vcu, int G) {
    const int tid = fresh_tid(), lane = tid & 63, wave = __builtin_amdgcn_readfirstlane(tid >> 6); LAS float* scr = (LAS float*)(lds + wave * 16384); const int gw = vcu * 8 + wave, NGW = G * 8;
    int base = 0;
    const float* w_in = INP(5) + (size_t)i * DM * EVEN_IN;
    conv_job(w_in, 0, DM, EVEN_IN, 0, 1536, (bf16_t*)(W + WE_IN), 0, 0, 0, nullptr, 0, 1, scr, gw, NGW, lane, base);
    conv_job(w_in, 0, DM, EVEN_IN, 1544, 512, (bf16_t*)(W + WE_IN), 0, 0, 1536, nullptr, 0, 1, scr, gw, NGW, lane, base);
    conv_job(INP(9) + (size_t)i * DM * DM, 0, DM, DM, 0, DM, (bf16_t*)(W + WE_OUT), 0, 0, 0, nullptr, 0, 1, scr, gw, NGW, lane, base);
    if (i == E4F8_PAIR) {
    conv_job8(INP(10) + (size_t)i * DM * FF, 0, DM, FF, FF, W + WE_GU, 0, 1, 0, S8_WGU, 1, (LAS unsigned char*)scr, gw, NGW, lane, base);
    conv_job8(INP(11) + (size_t)i * DM * FF, 0, DM, FF, FF, W + WE_GU, 0, 1, 128, S8_WGU, 1, (LAS unsigned char*)scr, gw, NGW, lane, base);
    } else {
    conv_job(INP(10) + (size_t)i * DM * FF, 0, DM, FF, 0, FF, (bf16_t*)(W + WE_GU), 0, 1, 0, nullptr, 0, 1, scr, gw, NGW, lane, base);
    conv_job(INP(11) + (size_t)i * DM * FF, 0, DM, FF, 0, FF, (bf16_t*)(W + WE_GU), 0, 1, 128, nullptr, 0, 1, scr, gw, NGW, lane, base);
    }
    conv_job8(INP(12) + (size_t)i * FF * DM, 0, FF, DM, DM, W + WE_DN, 0, 0, 0, S8_WDN, 1, (LAS unsigned char*)scr, gw, NGW, lane, base);
    conv_job(INP(7) + (size_t)i * 4 * 128 * 128, 128 * 128, 128, 128, 0, 128, (bf16_t*)(W + WE_POOL), 128 * 128, 0, 0, INP(8) + (size_t)i * 512, 128, 4, scr, gw, NGW, lane, base);
}
__device__ __forceinline__ void convert_odd(int i, unsigned char* W, LAS unsigned char* lds, int vcu, int G) {
    const int tid = fresh_tid(), lane = tid & 63, wave = __builtin_amdgcn_readfirstlane(tid >> 6); LAS float* scr = (LAS float*)(lds + wave * 16384); const int gw = vcu * 8 + wave, NGW = G * 8;
    int base = 0;
    conv_job8(INP(13) + (size_t)i * DM * 3 * DM, 0, DM, 3 * DM, 3 * DM, W + WO_IN, 0, 0, 0, S8_WGU, 1, (LAS unsigned char*)scr, gw, NGW, lane, base);
    conv_job(INP(14) + (size_t)i * DM * DM, 0, DM, DM, 0, DM, (bf16_t*)(W + WO_OUT), 0, 0, 0, nullptr, 0, 1, scr, gw, NGW, lane, base);
    conv_job8(INP(16) + (size_t)i * NEXP * DM * FF, (size_t)DM * FF, DM, FF, FF, W + WO_GU, (size_t)2 * FF * DM, 1, 0, S8_WGU, NEXP, (LAS unsigned char*)scr, gw, NGW, lane, base);
    conv_job8(INP(17) + (size_t)i * NEXP * DM * FF, (size_t)DM * FF, DM, FF, FF, W + WO_GU, (size_t)2 * FF * DM, 1, 128, S8_WGU, NEXP, (LAS unsigned char*)scr, gw, NGW, lane, base);
    conv_job8(INP(18) + (size_t)i * NEXP * FF * DM, (size_t)FF * DM, FF, DM, DM, W + WO_DN, (size_t)DM * FF, 0, 0, S8_WDN, NEXP, (LAS unsigned char*)scr, gw, NGW, lane, base);
}


#define NCV 384
#ifndef PMASK
#define PMASK 0xffffffffu
#endif
#define PH(k) if ((PMASK >> (k)) & 1u)
__global__ void __launch_bounds__(512, 2) trunk_fwd(Args a) {
    extern __shared__ __attribute__((aligned(16))) unsigned char lds_raw[];
    LAS unsigned char* lds = (LAS unsigned char*)lds_raw;
    volatile LAS unsigned* MISC = (volatile LAS unsigned*)(lds + MISC_OFF);
    const int tid = threadIdx.x;
    const int G0 = gridDim.x, bx0 = blockIdx.x;
    const int vcu0 = (bx0 % 8) * (G0 / 8) + bx0 / 8;
    for (int u = tid; u < (LDS_BYTES - MISC_OFF) / 4; u += 512) ((LAS unsigned*)(lds + MISC_OFF))[u] = 0u;
    __syncthreads();
    (void)xcd_barrier_post((unsigned*)(WSP + WS_CTL) + CW_BAR, MISC + 8);
#define GRID_BAR() do { XcdBarrier bar_; bar_.bar = (unsigned*)(WSP + WS_CTL) + CW_BAR; bar_.x = xb_xcc_id(); bar_.st = (volatile LAS unsigned*)(lds + MISC_OFF) + 8; xcd_barrier(bar_); } while (0)
#define G ls(G0)
#define bx ls(bx0)
#define vcu ls(vcu0)
#define XF OUTP
#define XB ((bf16_t*)(WSP + WS_XB))
#define WGT(off) ((const bf16_t*)(WSP + WS_W + (off)))
#define HC ((bf16_t*)(WSP + WS_BIG + BG_HC))
#define CAT ((bf16_t*)(WSP + WS_BIG + BG_CAT))
#define HID ((bf16_t*)(WSP + WS_BIG + BG_HID))
#define XS ((bf16_t*)(WSP + WS_XS))
#define XS8 (WSP + WS_BIG + BG_XS8)
#define YPRE ((bf16_t*)(WSP + WS_BIG + 256 * MiB))
#define HID8 (WSP + WS_BIG + BG_HID)
#define LOGF ((float*)(WSP + WS_LOGF))
#define FL ((float*)(WSP + WS_FL))
#define KMEAN ((float*)(WSP + WS_KMEAN))
#define RE ((unsigned*)(WSP + WS_RE))
#define RG ((f32x2*)(WSP + WS_RG))
#define RR ((unsigned*)(WSP + WS_RR))
#define POS ((i32x2*)(WSP + WS_POS))
#define CNT ((int*)(WSP + WS_CNT))
#define PB ((int*)(WSP + WS_PB))
#define QKV HC
#define OB CAT

    PH(0) convert_even(0, WSP + WS_W, lds, vcu, G);
    __syncthreads();
    PH(1) row_phase<RP_FORGET>(lds, vcu, INP(0), XF, XB, nullptr, nullptr, INP(5) + 1536, EVEN_IN, INP(6), LOGF, nullptr, nullptr, nullptr, nullptr, nullptr, nullptr, nullptr);
    GRID_BAR();

    for (int pair = 0; pair < 2; ++pair) {
        const int le = 2 * pair, lo = 2 * pair + 1;

        PH(2) if (vcu < 64) fox_scan(lds, vcu, LOGF, FL);
        PH(3) { pg8::Gemm g{XB, WGT(WE_IN), MTOK, 2048, DM}; pg8::StaticOrderT<8> S; S.init(MTOK, 2048, G, bx);
          pg8::EpiBf16 E{HC, 2048, 2, C2};
          pg8::gemm_phase<pg8::EpiBf16, pg8::StaticOrderT<8>, true, true>(lds, g, S, E); }
        GRID_BAR();


        PH(4) {
          gu32* qhead = (gu32*)(WSP + WS_CTL) + 64 + 64 * pair;
          volatile LAS unsigned* qslot = (volatile LAS unsigned*)(lds + MISC_OFF + 96);
#pragma unroll 1
          for (;;) {
              if (fresh_tid() == 0) qslot[0] = __hip_atomic_fetch_add(qhead, 1u, RLX_AGENT);
              __syncthreads();
              const int u = __builtin_amdgcn_readfirstlane((int)qslot[0]);
              __syncthreads();
              if (u >= 1024 + 512 + NCV) break;
              int v_;
              if (u < 4 * NCV) { if ((u & 3) == 3) { convert_odd(pair, WSP + WS_W, lds, u >> 2, NCV); continue; } v_ = u - (u >> 2); } else v_ = u - NCV;
              { const int u = v_;
              if (u < 1024) { const int h = 7 - (u >> 7), qb = 15 - ((u >> 3) & 15), b = u & 7;
                  fox_unit(lds, HC, HC + 512, HC + 1024, 2048, CAT, 1024, b, h, qb, FL + (size_t)(b * 8 + h) * SEQ); }
              else { const int v = u - 1024; pool_unit(lds, v >> 2, v & 3, HC, WGT(WE_POOL), CAT); } }
          } }
        GRID_BAR();


        PH(5) { pg8::Gemm g{CAT, WGT(WE_OUT), MTOK, DM, DM}; pg8::StaticOrderT<4> S; S.init(MTOK, DM, G, bx);
          pg8::EpiResid E{XB, YPRE, DM, ALPHA, 1.f};
          pg8::gemm_phase<pg8::EpiResid, pg8::StaticOrderT<4>, true, true>(lds, g, S, E); }
        GRID_BAR();
        PH(6) { if (pair == E4F8_PAIR) row_phase<RP_LN | RP_SRC_BF16 | RP_WRITE_X8>(lds, vcu, (const float*)YPRE, XF, XB, INP(1) + le * DM, INP(2) + le * DM, nullptr, 0, nullptr, nullptr, nullptr, nullptr, nullptr, nullptr, nullptr, nullptr, nullptr, XS8);
          else row_phase<RP_LN | RP_SRC_BF16>(lds, vcu, (const float*)YPRE, XF, XB, INP(1) + le * DM, INP(2) + le * DM, nullptr, 0, nullptr, nullptr, nullptr, nullptr, nullptr, nullptr, nullptr, nullptr, nullptr); }
        GRID_BAR();
        PH(7) { if (pair == E4F8_PAIR) { pg8::Gemm g{(const bf16_t*)XS8, WGT(WE_GU), MTOK, 2 * FF, DM / 2}; pg8::StaticOrderT<28> S; S.init(MTOK, 2 * FF, G, bx);
            pg8::EpiSwiGLU8 E{HID8, FF, 1.f / (S8_X * S8_WGU), S8_H};
            pg8::gemm_phase<pg8::EpiSwiGLU8, pg8::StaticOrderT<28>, true, true, true>(lds, g, S, E); }
          else { pg8::Gemm g{XB, WGT(WE_GU), MTOK, 2 * FF, DM}; pg8::StaticOrderT<28> S; S.init(MTOK, 2 * FF, G, bx);
            pg8::EpiSwiGLU8 E{HID8, FF, 1.f, S8_H};
            pg8::gemm_phase<pg8::EpiSwiGLU8, pg8::StaticOrderT<28>, true, true, false>(lds, g, S, E); } }
        GRID_BAR();
        PH(8) { pg8::Gemm g{(const bf16_t*)HID8, WGT(WE_DN), MTOK, DM, FF / 2}; pg8::StaticOrderT<4> S; S.init(MTOK, DM, G, bx);
          pg8::EpiResid E{XB, YPRE, DM, ALPHA, 1.f / (S8_H * S8_WDN)};
          pg8::gemm_phase<pg8::EpiResid, pg8::StaticOrderT<4>, true, true, true>(lds, g, S, E); }
        GRID_BAR();
        PH(9) row_phase<RP_LN | RP_SRC_BF16 | RP_WRITE_X8>(lds, vcu, (const float*)YPRE, XF, XB, INP(3) + le * DM, INP(4) + le * DM, nullptr, 0, nullptr, nullptr, nullptr, nullptr, nullptr, nullptr, nullptr, nullptr, nullptr, XS8);
        GRID_BAR();

        PH(11) { pg8::Gemm g{(const bf16_t*)XS8, WGT(WO_IN), MTOK, 3 * DM, DM / 2}; pg8::StaticOrderT<12> S; S.init(MTOK, 3 * DM, G, bx);
          pg8::EpiBf16 E{QKV, 3 * DM, 4, C2 / (S8_X * S8_WGU), 1.f / (S8_X * S8_WGU)};
          pg8::gemm_phase<pg8::EpiBf16, pg8::StaticOrderT<12>, true, true, true>(lds, g, S, E); }
        GRID_BAR();
        PH(12) kmean_unit(lds, vcu, QKV + DM, KMEAN);
        GRID_BAR();
        PH(13) moba_part(lds, vcu, QKV, QKV + DM, QKV + 2 * DM, 3 * DM, OB, DM, KMEAN, (bf16_t*)(WSP + WS_BIG + 256 * MiB), (f32x2*)(WSP + WS_XS));
        GRID_BAR();
        PH(14) { pg8::Gemm g{OB, WGT(WO_OUT), MTOK, DM, DM}; pg8::StaticOrderT<4> S; S.init(MTOK, DM, G, bx);
          pg8::EpiResid E{XB, YPRE, DM, ALPHA, 1.f};
          pg8::gemm_phase<pg8::EpiResid, pg8::StaticOrderT<4>, true, true>(lds, g, S, E); }
        GRID_BAR();
        PH(15) row_phase<RP_LN | RP_ROUTER | RP_SRC_BF16>(lds, vcu, (const float*)YPRE, XF, XB, INP(1) + lo * DM, INP(2) + lo * DM, INP(15) + (size_t)pair * DM * NEXP, NEXP, nullptr, nullptr, nullptr, nullptr, nullptr, RE, RG, RR, CNT);
        GRID_BAR();
        PH(16) moe_sort(lds, vcu, CNT, RE, RR, XB, XS8, POS, PB);
        GRID_BAR();
        { const int np = __builtin_amdgcn_readfirstlane(PB[8]);
          PH(17) { pg8::Gemm g{(const bf16_t*)XS8, WGT(WO_GU), np * 256, 2 * FF, DM / 2}; pg8::MoeOrderT<28> S; S.init(np, 2 * FF, G, bx, PB + 16);
            pg8::EpiSwiGLU8 E{HID8, FF, 1.f / (S8_X * S8_WGU), S8_H};
            pg8::gemm_phase<pg8::EpiSwiGLU8, pg8::MoeOrderT<28>, true, true, true>(lds, g, S, E); }
          GRID_BAR();
          PH(18) { pg8::Gemm g{(const bf16_t*)HID8, WGT(WO_DN), np * 256, DM, FF / 2}; pg8::MoeOrderT<4> S; S.init(np, DM, G, bx, PB + 16);
            pg8::EpiBf16 E{XS, DM, 1 << 30, 1.f / (S8_H * S8_WDN)};
            pg8::gemm_phase<pg8::EpiBf16, pg8::MoeOrderT<4>, true, true, true>(lds, g, S, E); }
          GRID_BAR(); }
        if (pair == 0) {
            PH(19) row_phase<RP_LN | RP_COMBINE | RP_FORGET | RP_SRC_BF16>(lds, vcu, (const float*)XB, XF, XB, INP(3) + lo * DM, INP(4) + lo * DM,
                INP(5) + (size_t)(pair + 1) * DM * EVEN_IN + 1536, EVEN_IN, INP(6) + (pair + 1) * 8, LOGF, XS, RG, POS, nullptr, nullptr, nullptr, nullptr);
            PH(20) convert_even(pair + 1, WSP + WS_W, lds, vcu, G);
            GRID_BAR();
        } else {
            PH(21) row_phase<RP_LN | RP_WRITE_XF | RP_COMBINE | RP_SRC_BF16>(lds, vcu, (const float*)XB, XF, XB, INP(3) + lo * DM, INP(4) + lo * DM,
                nullptr, 0, nullptr, nullptr, XS, RG, POS, nullptr, nullptr, nullptr, nullptr);
        }
    }
}

#undef G
#undef bx
#undef vcu
#undef XF
#undef XB
#undef HC
#undef CAT
#undef HID
#undef XS
#undef XS8
#undef YPRE
#undef HID8
#undef LOGF
#undef FL
#undef KMEAN
#undef RE
#undef RG
#undef RR
#undef POS
#undef CNT
#undef PB
#undef QKV
#undef OB
extern "C" void kernel_launch(void* const* d_in, const int* in_sizes, int n_in, void* d_out, int out_size, void* d_ws, size_t ws_size, hipStream_t stream) {
    static int grid = 0;
    if (grid == 0) {
        if (n_in != 19 || in_sizes[0] != MTOK * DM || out_size != MTOK * DM || ws_size < WS_END) { fprintf(stderr, "kernel_launch: unexpected shapes (n_in %d, out %d, ws %zu); nothing launched\n", n_in, out_size, ws_size); grid = -1; return; }
        int dev = 0, cus = 0, per_cu = 0;
        if (hipGetDevice(&dev) != hipSuccess || hipDeviceGetAttribute(&cus, hipDeviceAttributeMultiprocessorCount, dev) != hipSuccess) { grid = -1; return; }
        if (hipFuncSetAttribute((const void*)trunk_fwd, hipFuncAttributeMaxDynamicSharedMemorySize, LDS_BYTES) != hipSuccess) { fprintf(stderr, "kernel_launch: hipFuncSetAttribute failed\n"); grid = -1; return; }
        if (hipOccupancyMaxActiveBlocksPerMultiprocessor(&per_cu, (const void*)trunk_fwd, 512, LDS_BYTES) != hipSuccess || per_cu < 1) fprintf(stderr, "kernel_launch: occupancy query reports %d\n", per_cu);
        (void)hipGetLastError();
        grid = cus;
        if (grid != 256) { fprintf(stderr, "kernel_launch: built for 256 CUs, found %d; nothing launched\n", cus); grid = -1; return; }
    }
    if (grid < 0) return;
    if (hipMemsetAsync((char*)d_ws + WS_CTL, 0, CTL_ZERO_BYTES, stream) != hipSuccess) return;
    Args a{};
    for (int i = 0; i < 19; ++i) a.in[i] = (const float*)d_in[i];
    a.out = (float*)d_out; a.ws = (unsigned char*)d_ws;
    hipLaunchKernelGGL(trunk_fwd, dim3(grid), dim3(512), LDS_BYTES, stream, a);
}
```

```cpp
#include <hip/hip_runtime.h>
#include <cstdio>
#include <cstdint>

#define LAS __attribute__((address_space(3)))
#define GAS __attribute__((address_space(1)))
typedef unsigned short bf16_t;
typedef short bf16x8 __attribute__((ext_vector_type(8)));
typedef short s16x4 __attribute__((ext_vector_type(4)));
typedef float f32x4 __attribute__((ext_vector_type(4)));
typedef float f32x2 __attribute__((ext_vector_type(2)));
typedef float f32x16 __attribute__((ext_vector_type(16)));
typedef unsigned u32x4 __attribute__((ext_vector_type(4)));
typedef unsigned u32x2 __attribute__((ext_vector_type(2)));
typedef int i32x2 __attribute__((ext_vector_type(2)));

constexpr int NB = 8, SEQ = 4096, DM = 1024, MTOK = NB * SEQ, FF = 3584, NEXP = 8;
constexpr int FOXH = 8, MOBAH = 16, EVEN_IN = 2056;
constexpr float ALPHA = 1.6817928305074290f;
constexpr float LN_EPS = 1e-5f;
constexpr float LOG2E = 1.4426950408889634f;
constexpr float C2 = 0.125f * 1.4426950408889634f;
constexpr int MAXROWS = 2 * MTOK + NEXP * 256;

typedef __bf16 bf16x2_t __attribute__((ext_vector_type(2)));
__device__ __forceinline__ unsigned cvt_pk_bf16(float lo, float hi) { const f32x2 v = {lo, hi}; const bf16x2_t b = __builtin_convertvector(v, bf16x2_t); return __builtin_bit_cast(unsigned, b); }
__device__ __forceinline__ float bf_lo(unsigned u) { return __uint_as_float(u << 16); }
__device__ __forceinline__ float bf_hi(unsigned u) { return __uint_as_float(u & 0xffff0000u); }

__device__ __forceinline__ int ls(int x) { asm volatile("" : "+s"(x)); return x; }
__device__ __forceinline__ float lane_xor(float v, int lane, int o) { return __int_as_float(__builtin_amdgcn_ds_bpermute((lane ^ o) << 2, __float_as_int(v))); }
__device__ __forceinline__ int fresh_tid() { int t = threadIdx.x; asm volatile("" : "+v"(t)); return t; }

namespace pg8 {
#define PG8_LAS __attribute__((address_space(3)))
constexpr int BM = 256, BK = 64, HALF = 128, HTB = HALF * BK * 2, STAGE_BYTES = 8 * HTB, NXCD = 8, WGM = 8;
__host__ __device__ __forceinline__ int lds_byte(int r, int c) { const int st = (r >> 4) * 2 + (c >> 5), rr = r & 15, cc = c & 31, ob = rr * 64 + cc * 2; return st * 1024 + (ob ^ (((ob >> 9) & 1) << 5)); }
__host__ __device__ __forceinline__ void stage_rc(int b, int& R, int& C) { const int st = b / 1024, sb = b % 1024, swz = sb ^ (((sb >> 9) & 1) << 5); R = (st >> 1) * 16 + swz / 64; C = (st & 1) * 32 + (swz % 64) / 2; }
__host__ __device__ __forceinline__ int perm32(int rho) { const int n = rho >> 4, i = rho & 15; return 8 * (i >> 2) + 4 * n + (i & 3); }

struct Unit { int pm, pn, pb; };
struct Gemm { const bf16_t* A; const bf16_t* Bt; int M, N, K; };

template <int NN> struct StaticOrderT {
    int nM, nwg, G, c;
    __device__ void init(int M, int  , int G_, int c_) { nM = M / BM; nwg = nM * NN; G = G_; c = c_; }
    __device__ bool next(int i, Unit& u) const {
        const int L = i * G + c; if (L >= nwg) return false;
        int wgid = L; { const int q = nwg / NXCD, r = nwg % NXCD, xcd = wgid % NXCD, off = wgid / NXCD; wgid = (xcd < r ? xcd * (q + 1) : r * (q + 1) + (xcd - r) * q) + off; }
        constexpr int nig = WGM * NN; const int gid = wgid / nig, fm = gid * WGM, rem = wgid % nig, left = nM - fm;
        if (left >= WGM) { u.pm = fm + rem % WGM; u.pn = rem / WGM; } else { u.pm = fm + rem % left; u.pn = rem / left; }
        u.pb = u.pn; return true;
    }
    __device__ __forceinline__ void a_ready(const Unit&) const {}
    __device__ __forceinline__ void done(const Unit&) const {}
};
template <int NN> struct MoeOrderT {
    int nM, nwg, G, c; const PG8_LAS int* pe;
    __device__ __forceinline__ void init(int nPanels, int  , int G_, int c_, PG8_LAS int* pl) { nM = nPanels; nwg = nM * NN; G = G_; c = c_; pe = pl; }
    __device__ bool next(int i, Unit& u) const {
        const int L = i * G + c; if (L >= nwg) return false;
        int wgid = L; { const int q = nwg / NXCD, r = nwg % NXCD, xcd = wgid % NXCD, off = wgid / NXCD; wgid = (xcd < r ? xcd * (q + 1) : r * (q + 1) + (xcd - r) * q) + off; }
        constexpr int nig = WGM * NN; const int gid = wgid / nig, fm = gid * WGM, rem = wgid % nig, left = nM - fm;
        if (left >= WGM) { u.pm = fm + rem % WGM; u.pn = rem / WGM; } else { u.pm = fm + rem % left; u.pn = rem / left; }
        u.pb = __builtin_amdgcn_readfirstlane(pe[u.pm]) * NN + u.pn; return true;
    }
    __device__ __forceinline__ void a_ready(const Unit&) const {}
    __device__ __forceinline__ void done(const Unit&) const {}
};

typedef int i32x4v __attribute__((ext_vector_type(4)));
typedef int i32x8v __attribute__((ext_vector_type(8)));
__device__ __forceinline__ i32x8v cat8(const bf16x8& lo, const bf16x8& hi) { const i32x4v a = __builtin_bit_cast(i32x4v, lo), b = __builtin_bit_cast(i32x4v, hi); return __builtin_shufflevector(a, b, 0, 1, 2, 3, 4, 5, 6, 7); }
template <bool F8> __device__ __forceinline__ void mma_block(f32x4 (&acc)[4][2], const bf16x8 (&At)[4][2], const bf16x8 (&Bt)[2][2], const i32x8v (&At8)[4], const i32x8v (&Bt8)[2]) {
    if constexpr (!F8) {
#pragma unroll
        for (int m = 0; m < 4; ++m)
#pragma unroll
            for (int n = 0; n < 2; ++n)
#pragma unroll
                for (int k = 0; k < 2; ++k) acc[m][n] = __builtin_amdgcn_mfma_f32_16x16x32_bf16(Bt[n][k], At[m][k], acc[m][n], 0, 0, 0);
    } else {
#pragma unroll
        for (int m = 0; m < 4; ++m)
#pragma unroll
            for (int n = 0; n < 2; ++n) asm volatile("v_mfma_scale_f32_16x16x128_f8f6f4 %0, %1, %2, %0, %3, %3 op_sel_hi:[0,0,0]" : "+v"(acc[m][n]) : "v"(Bt8[n]), "v"(At8[m]), "v"(0x7f7f7f7f));
    }
}

struct EpiBf16 {
    static constexpr int NVM = 16;     static constexpr bool PERM = true, AFTER_DRAIN = false;
    bf16_t* O; int ldc; int nscale; float scale0; float scale1 = 1.f;
    __device__ __forceinline__ void operator()(const f32x4 (&acc)[2][2][4][2], const Unit& u, int wr, int wc, int fr, int fq) const {
        asm volatile("" : "+v"(fr), "+v"(fq));
        const int row0 = u.pm * BM + wr * 64 + fr; const int col0 = u.pn * BM + wc * 32 + 8 * fq;
        const float sc = (u.pn < nscale) ? scale0 : scale1;
#pragma unroll
        for (int ai = 0; ai < 2; ++ai)
#pragma unroll
            for (int m = 0; m < 4; ++m) { bf16_t* rowp = O + (size_t)(row0 + ai * HALF + m * 16) * ldc + col0;
#pragma unroll
                for (int bj = 0; bj < 2; ++bj) { const f32x4 v0 = acc[ai][bj][m][0] * sc, v1 = acc[ai][bj][m][1] * sc;
                    u32x4 w; w.x = cvt_pk_bf16(v0[0], v0[1]); w.y = cvt_pk_bf16(v0[2], v0[3]); w.z = cvt_pk_bf16(v1[0], v1[1]); w.w = cvt_pk_bf16(v1[2], v1[3]);
                    *(u32x4*)(rowp + bj * HALF) = w; } }
    }
};
__device__ __forceinline__ float silu_mul(float g, float u) { const float e = __builtin_amdgcn_exp2f(-g * LOG2E); return g * __builtin_amdgcn_rcpf(1.0f + e) * u; }
struct EpiSwiGLU {
    static constexpr int NVM = 8;     static constexpr bool PERM = true, AFTER_DRAIN = false;
    bf16_t* O; int ldc;
    __device__ __forceinline__ void operator()(const f32x4 (&acc)[2][2][4][2], const Unit& u, int wr, int wc, int fr, int fq) const {
        asm volatile("" : "+v"(fr), "+v"(fq));
        const int row0 = u.pm * BM + wr * 64 + fr; const int col0 = u.pn * HALF + wc * 32 + 8 * fq;
#pragma unroll
        for (int ai = 0; ai < 2; ++ai)
#pragma unroll
            for (int m = 0; m < 4; ++m) { bf16_t* rowp = O + (size_t)(row0 + ai * HALF + m * 16) * ldc + col0;
                const f32x4 g0 = acc[ai][0][m][0], g1 = acc[ai][0][m][1], u0 = acc[ai][1][m][0], u1 = acc[ai][1][m][1];
                u32x4 w; w.x = cvt_pk_bf16(silu_mul(g0[0], u0[0]), silu_mul(g0[1], u0[1])); w.y = cvt_pk_bf16(silu_mul(g0[2], u0[2]), silu_mul(g0[3], u0[3]));
                w.z = cvt_pk_bf16(silu_mul(g1[0], u1[0]), silu_mul(g1[1], u1[1])); w.w = cvt_pk_bf16(silu_mul(g1[2], u1[2]), silu_mul(g1[3], u1[3]));
                *(u32x4*)rowp = w; }
    }
};
__device__ __forceinline__ float clamp448(float x) { return fminf(fmaxf(x, -448.f), 448.f); }
__device__ __forceinline__ unsigned pack4_fp8(float a, float b, float c, float d) { int w = 0; w = __builtin_amdgcn_cvt_pk_fp8_f32(clamp448(a), clamp448(b), w, false); w = __builtin_amdgcn_cvt_pk_fp8_f32(clamp448(c), clamp448(d), w, true); return (unsigned)w; }
struct EpiSwiGLU8 {
    static constexpr int NVM = 8;     static constexpr bool PERM = true, AFTER_DRAIN = false;
    unsigned char* O; int ldc; float inscale, outscale;
    __device__ __forceinline__ void operator()(const f32x4 (&acc)[2][2][4][2], const Unit& u, int wr, int wc, int fr, int fq) const {
        asm volatile("" : "+v"(fr), "+v"(fq));
        const int row0 = u.pm * BM + wr * 64 + fr; const int col0 = u.pn * HALF + wc * 32 + 8 * fq;
        const float os = outscale * inscale;
#pragma unroll
        for (int ai = 0; ai < 2; ++ai)
#pragma unroll
            for (int m = 0; m < 4; ++m) { unsigned char* rowp = O + (size_t)(row0 + ai * HALF + m * 16) * ldc + col0;
                const f32x4 g0 = acc[ai][0][m][0] * inscale, g1 = acc[ai][0][m][1] * inscale, u0 = acc[ai][1][m][0] * os, u1 = acc[ai][1][m][1] * os;
                u32x2 w; w.x = pack4_fp8(silu_mul(g0[0], u0[0]), silu_mul(g0[1], u0[1]), silu_mul(g0[2], u0[2]), silu_mul(g0[3], u0[3]));
                w.y = pack4_fp8(silu_mul(g1[0], u1[0]), silu_mul(g1[1], u1[1]), silu_mul(g1[2], u1[2]), silu_mul(g1[3], u1[3]));
                *(u32x2*)rowp = w; }
    }
};
struct EpiResid {
    static constexpr int NVM = 32;     static constexpr bool PERM = true, AFTER_DRAIN = false;
    const bf16_t* base; bf16_t* out; int ldc; float alpha, accscale;
    __device__ __forceinline__ void operator()(const f32x4 (&acc)[2][2][4][2], const Unit& u, int wr, int wc, int fr, int fq) const {
        asm volatile("" : "+v"(fr), "+v"(fq));
        const int row0 = u.pm * BM + wr * 64 + fr; const int col0 = u.pn * BM + wc * 32 + 8 * fq;
#pragma unroll
        for (int ai = 0; ai < 2; ++ai)
#pragma unroll
            for (int m = 0; m < 4; ++m) { const size_t off = (size_t)(row0 + ai * HALF + m * 16) * ldc + col0;
                u32x4 bs[2];
#pragma unroll
                for (int bj = 0; bj < 2; ++bj) bs[bj] = *(const u32x4*)(base + off + bj * HALF);
#pragma unroll
                for (int bj = 0; bj < 2; ++bj) { const f32x4 v0 = acc[ai][bj][m][0] * accscale, v1 = acc[ai][bj][m][1] * accscale; const u32x4 b = bs[bj];
                    u32x4 w; w.x = cvt_pk_bf16(bf_lo(b.x) * alpha + v0[0], bf_hi(b.x) * alpha + v0[1]); w.y = cvt_pk_bf16(bf_lo(b.y) * alpha + v0[2], bf_hi(b.y) * alpha + v0[3]);
                    w.z = cvt_pk_bf16(bf_lo(b.z) * alpha + v1[0], bf_hi(b.z) * alpha + v1[1]); w.w = cvt_pk_bf16(bf_lo(b.w) * alpha + v1[2], bf_hi(b.w) * alpha + v1[3]);
                    *(u32x4*)(out + off + bj * HALF) = w; }
                asm volatile("" ::: "memory"); }
    }
};
template <class Epi, class Sched, bool ALIGN_EPI = false, bool SP2 = false, bool F8 = false>
__device__ __forceinline__ void gemm_phase(PG8_LAS unsigned char* lds, const Gemm g, const Sched& S, const Epi& E) {
    const int tid = fresh_tid(), wid = __builtin_amdgcn_readfirstlane(tid >> 6), lane = tid & 63, wr = wid >> 2, wc = wid & 3, fr = lane & 15, fq = lane >> 4;
    const int K = g.K, nt = K / BK;
    unsigned voffA[2], voffB[2];
#pragma unroll
    for (int i = 0; i < 2; ++i) { int R, C; stage_rc(tid * 16 + i * 8192, R, C); const int Rb = Epi::PERM ? ((R & ~31) + perm32(R & 31)) : R;
        voffA[i] = (unsigned)(R * K + C) * 2u; voffB[i] = (unsigned)(Rb * K + C) * 2u; }
    const size_t kstep = (size_t)(BK * 2);
    const size_t hstep = (size_t)HALF * K * 2;
    const size_t tstep = 2 * hstep;
    const unsigned ldsw = (unsigned)wid * 1024u;
    const int aoff = lds_byte(wr * 64 + fr, fq * 8), boff = lds_byte(wc * 32 + fr, fq * 8);
#define PG8_SA(b, h) (((b) * 2 + (h)) * HTB)
#define PG8_SB(b, h) ((4 + (b) * 2 + (h)) * HTB)
#define PG8_STAGE(bufoff, gbase, voff) do { _Pragma("unroll") for (int _i = 0; _i < 2; ++_i) \
        __builtin_amdgcn_global_load_lds((const unsigned*)((const char*)(gbase) + (voff)[_i]), (PG8_LAS unsigned*)(lds + (bufoff) + ldsw + _i * 8192), 16, 0, 0); } while (0)
#define PG8_LDA(dst, b, h) do { if constexpr (!F8) { _Pragma("unroll") for (int m = 0; m < 4; ++m) _Pragma("unroll") for (int k = 0; k < 2; ++k) dst[m][k] = *(const PG8_LAS bf16x8*)(lds + PG8_SA(b, h) + aoff + m * 2048 + k * 1024); } \
        else { _Pragma("unroll") for (int m = 0; m < 4; ++m) { const i32x4v lo_ = *(const PG8_LAS i32x4v*)(lds + PG8_SA(b, h) + aoff + m * 2048), hi_ = *(const PG8_LAS i32x4v*)(lds + PG8_SA(b, h) + aoff + m * 2048 + 1024); dst##8[m] = __builtin_shufflevector(lo_, hi_, 0, 1, 2, 3, 4, 5, 6, 7); } } } while (0)
#define PG8_LDB(dst, b, h) do { if constexpr (!F8) { _Pragma("unroll") for (int n = 0; n < 2; ++n) _Pragma("unroll") for (int k = 0; k < 2; ++k) dst[n][k] = *(const PG8_LAS bf16x8*)(lds + PG8_SB(b, h) + boff + n * 2048 + k * 1024); } \
        else { _Pragma("unroll") for (int n = 0; n < 2; ++n) { const i32x4v lo_ = *(const PG8_LAS i32x4v*)(lds + PG8_SB(b, h) + boff + n * 2048), hi_ = *(const PG8_LAS i32x4v*)(lds + PG8_SB(b, h) + boff + n * 2048 + 1024); dst##8[n] = __builtin_shufflevector(lo_, hi_, 0, 1, 2, 3, 4, 5, 6, 7); } } } while (0)
#define PG8_MMA(ai, bj, At, Bt) do { __builtin_amdgcn_s_setprio(1); mma_block<F8>(acc[ai][bj], At, Bt, At##8, Bt##8); __builtin_amdgcn_s_setprio(0); } while (0)
#define PG8_WAIT_V(n) asm volatile("s_waitcnt vmcnt(" #n ")" ::: "memory")
#define PG8_WAIT_VN(n) asm volatile("s_waitcnt vmcnt(%0)" :: "n"(n) : "memory")
#define PG8_WAIT_L(n) asm volatile("s_waitcnt lgkmcnt(" #n ")" ::: "memory")
#define PG8_BAR __builtin_amdgcn_s_barrier()
#define PG8_SCHED __builtin_amdgcn_sched_barrier(0)
    Unit cur, nxt; int ui = 0;
    if (!S.next(0, cur)) return;
    f32x4 acc[2][2][4][2];
#pragma unroll
    for (int a = 0; a < 2; ++a)
#pragma unroll
        for (int b = 0; b < 2; ++b)
#pragma unroll
            for (int m = 0; m < 4; ++m)
#pragma unroll
                for (int n = 0; n < 2; ++n) acc[a][b][m][n] = (f32x4){0.f, 0.f, 0.f, 0.f};
    bf16x8 At[4][2], B0[2][2], B1[2][2];
    i32x8v At8[4], B08[2], B18[2];
    const char* cA = (const char*)g.A + (size_t)cur.pm * tstep; const char* cB = (const char*)g.Bt + (size_t)cur.pb * tstep;
    S.a_ready(cur);
    if constexpr (SP2) {
        PG8_STAGE(PG8_SB(0, 0), cB, voffB); PG8_STAGE(PG8_SB(0, 1), cB + hstep, voffB); PG8_STAGE(PG8_SA(0, 0), cA, voffA); PG8_STAGE(PG8_SA(0, 1), cA + hstep, voffA);
        PG8_STAGE(PG8_SB(1, 0), cB + kstep, voffB); PG8_STAGE(PG8_SA(1, 0), cA + kstep, voffA); PG8_STAGE(PG8_SB(1, 1), cB + hstep + kstep, voffB); PG8_STAGE(PG8_SA(1, 1), cA + hstep + kstep, voffA);
        if (wr == 1) PG8_BAR;
        PG8_WAIT_V(0); PG8_BAR;
        PG8_BAR;
    } else {
        PG8_STAGE(PG8_SB(0, 0), cB, voffB); PG8_STAGE(PG8_SA(0, 0), cA, voffA); PG8_STAGE(PG8_SB(0, 1), cB + hstep, voffB); PG8_STAGE(PG8_SA(0, 1), cA + hstep, voffA);
        if (wr == 1) PG8_BAR;
        PG8_WAIT_V(4); PG8_BAR;
        PG8_STAGE(PG8_SB(1, 0), cB + kstep, voffB); PG8_STAGE(PG8_SA(1, 0), cA + kstep, voffA); PG8_STAGE(PG8_SB(1, 1), cB + hstep + kstep, voffB);
        PG8_WAIT_V(6); PG8_BAR;
    }
    for (;;) {
        const bool has_next = S.next(ui + 1, nxt);
        const char* nA = has_next ? (const char*)g.A + (size_t)nxt.pm * tstep : cA; const char* nB = has_next ? (const char*)g.Bt + (size_t)nxt.pb * tstep : cB;
        if constexpr (SP2) {
#define PG8_WAIT_V8X() do { if (t == 0) PG8_WAIT_VN(8 + Epi::NVM); else PG8_WAIT_V(8); } while (0)
#pragma unroll 1
        for (int t = 0; t < nt; t += 2) {
            const bool last = (t == nt - 2);
            const char* a1 = cA + (size_t)(t + 1) * kstep;
            const char* a2 = last ? nA : cA + (size_t)(t + 2) * kstep; const char* b2 = last ? nB : cB + (size_t)(t + 2) * kstep;
            const char* a3 = a2 + kstep; const char* b3 = b2 + kstep;
            if (last && has_next) S.a_ready(nxt);
            PG8_LDB(B0, 0, 0); PG8_LDB(B1, 0, 1); PG8_SCHED; PG8_LDA(At, 0, 0); if (t != 0) PG8_STAGE(PG8_SA(1, 1), a1 + hstep, voffA);
            PG8_WAIT_V8X(); PG8_WAIT_L(0); PG8_BAR; PG8_MMA(0, 0, At, B0); PG8_MMA(0, 1, At, B1); PG8_BAR; PG8_SCHED;
            PG8_LDA(At, 0, 1); PG8_STAGE(PG8_SB(0, 0), b2, voffB); PG8_STAGE(PG8_SB(0, 1), b2 + hstep, voffB); PG8_STAGE(PG8_SA(0, 0), a2, voffA);
            PG8_WAIT_V8X(); PG8_WAIT_L(0); PG8_BAR; PG8_MMA(1, 0, At, B0); PG8_MMA(1, 1, At, B1); PG8_BAR; PG8_SCHED;
            PG8_LDB(B0, 1, 0); PG8_LDB(B1, 1, 1); PG8_SCHED; PG8_LDA(At, 1, 0); PG8_STAGE(PG8_SA(0, 1), a2 + hstep, voffA);
            PG8_WAIT_V8X(); PG8_WAIT_L(0); PG8_BAR; PG8_MMA(0, 0, At, B0); PG8_MMA(0, 1, At, B1); PG8_BAR; PG8_SCHED;
            PG8_LDA(At, 1, 1); PG8_STAGE(PG8_SB(1, 0), b3, voffB); PG8_STAGE(PG8_SB(1, 1), b3 + hstep, voffB); PG8_STAGE(PG8_SA(1, 0), a3, voffA);
            PG8_WAIT_V(8); PG8_WAIT_L(0); PG8_BAR; PG8_MMA(1, 0, At, B0); PG8_MMA(1, 1, At, B1); PG8_BAR; PG8_SCHED;
        }
#undef PG8_WAIT_V8X
        } else {
        for (int t = 0; t < nt; t += 2) {
            const bool last = (t == nt - 2);
            const char* a1 = cA + (size_t)(t + 1) * kstep;
            const char* a2 = last ? nA : cA + (size_t)(t + 2) * kstep; const char* b2 = last ? nB : cB + (size_t)(t + 2) * kstep;
            const char* a3 = a2 + kstep; const char* b3 = b2 + kstep;
            if (last && has_next) S.a_ready(nxt);
            PG8_LDB(B0, 0, 0); PG8_SCHED; PG8_LDA(At, 0, 0); PG8_STAGE(PG8_SA(1, 1), a1 + hstep, voffA);
            PG8_WAIT_L(8); PG8_BAR; PG8_WAIT_L(0); PG8_MMA(0, 0, At, B0); PG8_BAR; PG8_SCHED;
            PG8_LDB(B1, 0, 1); PG8_STAGE(PG8_SB(0, 0), b2, voffB);
            PG8_BAR; PG8_WAIT_L(0); PG8_MMA(0, 1, At, B1); PG8_BAR;
            PG8_LDA(At, 0, 1); PG8_STAGE(PG8_SA(0, 0), a2, voffA);
            PG8_BAR; PG8_WAIT_L(0); PG8_MMA(1, 0, At, B0); PG8_BAR; PG8_SCHED;
            PG8_STAGE(PG8_SB(0, 1), b2 + hstep, voffB);
            PG8_WAIT_V(6); PG8_BAR; PG8_MMA(1, 1, At, B1); PG8_BAR;
            PG8_LDB(B0, 1, 0); PG8_SCHED; PG8_LDA(At, 1, 0); PG8_STAGE(PG8_SA(0, 1), a2 + hstep, voffA);
            PG8_WAIT_L(8); PG8_BAR; PG8_WAIT_L(0); PG8_MMA(0, 0, At, B0); PG8_BAR; PG8_SCHED;
            PG8_LDB(B1, 1, 1); PG8_STAGE(PG8_SB(1, 0), b3, voffB);
            PG8_BAR; PG8_WAIT_L(0); PG8_MMA(0, 1, At, B1); PG8_BAR;
            PG8_LDA(At, 1, 1); PG8_STAGE(PG8_SA(1, 0), a3, voffA);
            PG8_BAR; PG8_WAIT_L(0); PG8_MMA(1, 0, At, B0); PG8_BAR; PG8_SCHED;
            PG8_STAGE(PG8_SB(1, 1), b3 + hstep, voffB);
            PG8_WAIT_V(6); PG8_BAR; PG8_MMA(1, 1, At, B1); PG8_BAR;
        }
        }
        if constexpr (SP2) PG8_STAGE(PG8_SA(1, 1), nA + kstep + hstep, voffA);
        if constexpr (F8) asm volatile("s_nop 15\n\ts_nop 15" ::: "memory");
        if constexpr (ALIGN_EPI) { if (wr == 0) PG8_BAR; }
        if constexpr (!Epi::AFTER_DRAIN) { E(acc, cur, wr, wc, fr, fq); S.done(cur); }
        if (!has_next) break;
#pragma unroll
        for (int a = 0; a < 2; ++a)
#pragma unroll
            for (int b = 0; b < 2; ++b)
#pragma unroll
                for (int m = 0; m < 4; ++m)
#pragma unroll
                    for (int n = 0; n < 2; ++n) acc[a][b][m][n] = (f32x4){0.f, 0.f, 0.f, 0.f};
        cur = nxt; cA = nA; cB = nB; ++ui;
        if constexpr (ALIGN_EPI) { if (wr == 1) PG8_BAR; }
    }
    PG8_WAIT_V(0);
    if constexpr (!ALIGN_EPI) { if (wr == 0) PG8_BAR; }
    PG8_BAR;
    if constexpr (Epi::AFTER_DRAIN) { E.fused(acc, cur, wr, wc, fr, fq, lds, wid, lane); S.done(cur); }
#undef PG8_SA
#undef PG8_SB
#undef PG8_STAGE
#undef PG8_LDA
#undef PG8_LDB
#undef PG8_MMA
#undef PG8_WAIT_V
#undef PG8_WAIT_L
#undef PG8_WAIT_VN
#undef PG8_BAR
#undef PG8_SCHED
}
}

constexpr size_t MiB = 1u << 20;
constexpr size_t WS_CTL = 0, CTL_ZERO_BYTES = 256 * 1024;
constexpr size_t WS_LOGF = 4 * MiB;
constexpr size_t WS_FL = 5 * MiB;
constexpr size_t WS_KMEAN = 6 * MiB;
constexpr size_t WS_RE = 7 * MiB;
constexpr size_t WS_RG = 7 * MiB + 256 * 1024;
constexpr size_t WS_RR = 7 * MiB + 512 * 1024;
constexpr size_t WS_POS = 7 * MiB + 768 * 1024;
constexpr size_t WS_CNT = 8 * MiB;
constexpr size_t WS_PB = 8 * MiB + 64 * 1024;
constexpr size_t WS_W = 16 * MiB;
constexpr size_t WS_XB = 192 * MiB;
constexpr size_t WS_BIG = 256 * MiB;
constexpr size_t WS_XS = 718 * MiB;
constexpr size_t WS_END = 850 * MiB;
static_assert(WS_BIG + (size_t)MAXROWS * FF * 2 <= WS_XS && WS_XS + (size_t)MAXROWS * DM * 2 <= WS_END, "d_ws map");
constexpr size_t WE_IN = 0, WE_OUT = 4 * MiB, WE_GU = 6 * MiB, WE_DN = 20 * MiB, WE_POOL = 27 * MiB;
constexpr size_t WO_IN = 28 * MiB, WO_OUT = 34 * MiB, WO_GU = 36 * MiB, WO_DN = 92 * MiB;
constexpr float S8_X = 16.f, S8_WGU = 256.f, S8_H = 8.f, S8_WDN = 1024.f;
constexpr size_t BG_HC = 0, BG_CAT = 192 * MiB, BG_HID = 0, BG_XS8 = 320 * MiB, BG_XB8 = 128 * MiB;
constexpr int CW_BAR = 1024;

constexpr int RING_BYTES = 131072;
constexpr int MISC_OFF = RING_BYTES;
constexpr int LDS_BYTES = 147456;

typedef GAS unsigned gu32;
#define RLX_AGENT __ATOMIC_RELAXED, __HIP_MEMORY_SCOPE_AGENT
#define LDS_WAIT() asm volatile("s_waitcnt lgkmcnt(0)" ::: "memory")
#define XB_TMO      128
#define XB_XCNT(j)  (256  + 64 * (j))
#define XB_XSUB(j)  (1280 + 64 * (j))
#define XB_XGEN(j)  (2304 + 64 * (j))
#define XB_TOP      3328
#define XB_TOPGEN   3392
#define XCD_BAR_WORDS 3456
#define XB_SPIN_CAP (1u << 18)

__device__ __forceinline__ unsigned xb_ld(unsigned* p)              { return __hip_atomic_load(p, __ATOMIC_RELAXED, __HIP_MEMORY_SCOPE_AGENT); }
__device__ __forceinline__ unsigned xb_add(unsigned* p, unsigned v) { return __hip_atomic_fetch_add(p, v, __ATOMIC_RELAXED, __HIP_MEMORY_SCOPE_AGENT); }
__device__ __forceinline__ unsigned xb_xcc_id() { return (unsigned)__builtin_amdgcn_s_getreg((3 << 11) | 20) & 0xFu; }
#define XB_SPIN(cond, bar) do { unsigned _sp = 0; while (cond) { __builtin_amdgcn_s_sleep(1); \
    if ((++_sp & 255u) == 0u) { if (xb_ld(&(bar)[XB_TMO])) break; if (_sp > XB_SPIN_CAP) { atomicAdd(&(bar)[XB_TMO], 1u); break; } } } } while (0)

struct XcdBarrier {
    unsigned* bar; unsigned x;
    volatile LAS unsigned* st;
};

__device__ __forceinline__ XcdBarrier xcd_barrier_post(unsigned* bar, volatile LAS unsigned* st) {
    XcdBarrier b; b.bar = bar; b.x = xb_xcc_id(); b.st = st;
    if (threadIdx.x == 0) (void)xb_add(&bar[XB_XCNT(b.x)], 1u);
    return b;
}
__device__ __forceinline__ void xcd_barrier_complete(unsigned* bar, unsigned x, unsigned& nloc, unsigned& nx) {
    const unsigned G = gridDim.x * gridDim.y * gridDim.z;
    unsigned sum, cnt, mine, sp = 0u;
    for (;;) {
        sum = 0u; cnt = 0u; mine = 0u;
#pragma unroll
        for (unsigned j = 0; j < 16; ++j) { const unsigned c = xb_ld(&bar[XB_XCNT(j)]); sum += c; cnt += (c > 0u) ? 1u : 0u; mine = (j == x) ? c : mine; }
        if (sum == G) break;
        __builtin_amdgcn_s_sleep(1);
        if ((++sp & 255u) == 0u) { if (xb_ld(&bar[XB_TMO])) break; if (sp > XB_SPIN_CAP) { atomicAdd(&bar[XB_TMO], 1u); break; } }
    }
    nloc = mine > 0u ? mine : 1u; nx = cnt > 0u ? cnt : 1u;
}

__device__ __forceinline__ void xcd_barrier(const XcdBarrier& b) {
    asm volatile("s_waitcnt vmcnt(0)" ::: "memory");
    __syncthreads();
    if (threadIdx.x == 0) {
        unsigned* bar = b.bar;
        __builtin_amdgcn_s_waitcnt(0);
        unsigned nloc = b.st[0], nx = b.st[1];
        if (nloc == 0u) { xcd_barrier_complete(bar, b.x, nloc, nx); b.st[0] = nloc; b.st[1] = nx; }
        const unsigned old = xb_add(&bar[XB_XSUB(b.x)], 1u);
        const unsigned gen = old / nloc;
        if (old + 1u == (gen + 1u) * nloc) {
            __builtin_amdgcn_fence(__ATOMIC_RELEASE, "agent");
            asm volatile("s_waitcnt vmcnt(0)" ::: "memory");
            const unsigned og = xb_add(&bar[XB_TOP], 1u);
            const unsigned tg = og / nx;
            if (og + 1u == (tg + 1u) * nx) xb_add(&bar[XB_TOPGEN], 1u);
            else XB_SPIN(xb_ld(&bar[XB_TOPGEN]) == tg, bar);
            __builtin_amdgcn_fence(__ATOMIC_ACQUIRE, "agent");
            xb_add(&bar[XB_XGEN(b.x)], 1u);
            asm volatile("s_waitcnt vmcnt(0)" ::: "memory");
        } else {
            XB_SPIN(xb_ld(&bar[XB_XGEN(b.x)]) == gen, bar);
            __builtin_amdgcn_fence(__ATOMIC_ACQUIRE, "agent");
            asm volatile("s_waitcnt vmcnt(0)" ::: "memory");
        }
    }
    __syncthreads();
}

__device__ __forceinline__ float wave_sum(float v, int lane) {
#pragma unroll
    for (int o = 1; o < 64; o <<= 1) v += lane_xor(v, lane, o);
    return v;
}
__device__ __forceinline__ void transpose_item(const float* W, int K, int ld, int col0, int N, bf16_t* WT, int mode, int rowoff, const float* scale, LAS float* scr, int item, int lane) {
    const int nblk = N / 32, kb = item / nblk, nb = item % nblk, k0 = 64 * kb, n0 = 32 * nb;
    float tv[32];
#pragma unroll
    for (int i = 0; i < 32; ++i) { const int kk = 2 * i + (lane >> 5); tv[i] = __builtin_nontemporal_load(W + (size_t)(k0 + kk) * ld + col0 + n0 + (lane & 31)); }
    __builtin_amdgcn_sched_barrier(0);
#pragma unroll
    for (int i = 0; i < 32; ++i) { const int kk = 2 * i + (lane >> 5); scr[kk * 33 + (lane & 31)] = tv[i]; }
    LDS_WAIT(); asm volatile("" ::: "memory");
    const int c = lane & 7;
    const int r0 = (mode == 0) ? (rowoff + n0) : (256 * (n0 >> 7) + (n0 & 127) + rowoff);
#pragma unroll
    for (int j = 0; j < 4; ++j) { const int n = (lane >> 3) + 8 * j; const LAS float* s = scr + (8 * c) * 33 + n;
        const float sc = scale ? scale[n0 + n] : 1.f;
        u32x4 o; o.x = cvt_pk_bf16(s[0 * 33] * sc, s[1 * 33] * sc); o.y = cvt_pk_bf16(s[2 * 33] * sc, s[3 * 33] * sc); o.z = cvt_pk_bf16(s[4 * 33] * sc, s[5 * 33] * sc); o.w = cvt_pk_bf16(s[6 * 33] * sc, s[7 * 33] * sc);
        *(u32x4*)(WT + (size_t)(r0 + n) * K + k0 + 8 * c) = o; }
    LDS_WAIT(); asm volatile("" ::: "memory");
}
constexpr int T8_PITCH = 136;
__device__ __forceinline__ void transpose_item8(const float* W, int K, int ld, int N, unsigned char* WT, int mode, int rowoff, float mul, LAS unsigned char* scr, int item, int lane) {
    const int nblk = N / 64, kb = item / nblk, nb = item % nblk, k0 = 128 * kb, n0 = 64 * nb;
    const int g = lane >> 4, l16 = lane & 15;
    const float* src = W + (size_t)(k0 + 2 * g) * ld + n0 + 4 * l16;
    f32x4 ra[16], rb[16];
#pragma unroll
    for (int it = 0; it < 16; ++it) { ra[it] = __builtin_nontemporal_load((const f32x4*)(src + (size_t)(8 * it) * ld)); rb[it] = __builtin_nontemporal_load((const f32x4*)(src + (size_t)(8 * it + 1) * ld)); }
    __builtin_amdgcn_sched_barrier(0);
#pragma unroll
    for (int it = 0; it < 16; ++it) {
        const f32x4 a = ra[it] * mul, b = rb[it] * mul;
        int w0 = 0, w1 = 0;
        w0 = __builtin_amdgcn_cvt_pk_fp8_f32(pg8::clamp448(a.x), pg8::clamp448(b.x), w0, false); w0 = __builtin_amdgcn_cvt_pk_fp8_f32(pg8::clamp448(a.y), pg8::clamp448(b.y), w0, true);
        w1 = __builtin_amdgcn_cvt_pk_fp8_f32(pg8::clamp448(a.z), pg8::clamp448(b.z), w1, false); w1 = __builtin_amdgcn_cvt_pk_fp8_f32(pg8::clamp448(a.w), pg8::clamp448(b.w), w1, true);
        *(LAS u32x2*)(scr + (4 * it + g) * T8_PITCH + l16 * 8) = (u32x2){(unsigned)w0, (unsigned)w1};
    }
    LDS_WAIT(); asm volatile("" ::: "memory");
    const int r0 = (mode == 0) ? (rowoff + n0) : (256 * (n0 >> 7) + (n0 & 127) + rowoff);
    const LAS unsigned char* rd = scr + (l16 >> 2) * T8_PITCH + (l16 & 3) * 8;
#pragma unroll
    for (int t = 0; t < 8; ++t) { const int cb = t >> 1, piece = (t & 1) * 4 + g;
        const LAS unsigned char* p = rd + (piece * 8) * T8_PITCH + cb * 32;
        const s16x4 lo = __builtin_bit_cast(s16x4, __builtin_amdgcn_ds_read_tr16_b64_v4i16((LAS s16x4*)p)), hi = __builtin_bit_cast(s16x4, __builtin_amdgcn_ds_read_tr16_b64_v4i16((LAS s16x4*)(p + 4 * T8_PITCH)));
        const u32x2 l2 = __builtin_bit_cast(u32x2, lo), h2 = __builtin_bit_cast(u32x2, hi);
        *(u32x4*)(WT + (size_t)(r0 + cb * 16 + l16) * K + k0 + piece * 16) = (u32x4){l2.x, l2.y, h2.x, h2.y}; }
    LDS_WAIT(); asm volatile("" ::: "memory");
}
__device__ __forceinline__ void conv_job8(const float* W, size_t wstride, int K, int ld, int N, unsigned char* WT, size_t tstride, int mode, int rowoff, float mul, int nbatch,
                                          LAS unsigned char* scr, int gw, int NGW, int lane, int& base) {
    const int per = (K / 128) * (N / 64), total = per * nbatch;
    int first = (gw - base) % NGW; if (first < 0) first += NGW;
    for (int it = first; it < total; it += NGW) { const int bi = it / per, r = it - bi * per;
        transpose_item8(W + bi * wstride, K, ld, N, WT + bi * tstride, mode, rowoff, mul, scr, r, lane); }
    base = (base + total) % NGW;
}
__device__ __forceinline__ void conv_job(const float* W, size_t wstride, int K, int ld, int col0, int N, bf16_t* WT, size_t tstride, int mode, int rowoff, const float* scale, size_t sstride, int nbatch,
                                         LAS float* scr, int gw, int NGW, int lane, int& base) {
    const int per = (K / 64) * (N / 32), total = per * nbatch;
    int first = (gw - base) % NGW; if (first < 0) first += NGW;
    for (int it = first; it < total; it += NGW) { const int bi = it / per, r = it - bi * per;
        transpose_item(W + bi * wstride, K, ld, col0, N, WT + bi * tstride, mode, rowoff, scale ? scale + bi * sstride : nullptr, scr, r, lane); }
    base = (base + total) % NGW;
}

__device__ __forceinline__ float wave_sum_dpp(float v) {
    v += __int_as_float(__builtin_amdgcn_update_dpp(0, __float_as_int(v), 0xB1, 0xf, 0xf, false));
    v += __int_as_float(__builtin_amdgcn_update_dpp(0, __float_as_int(v), 0x4E, 0xf, 0xf, false));
    v += __int_as_float(__builtin_amdgcn_update_dpp(0, __float_as_int(v), 0x141, 0xf, 0xf, false));
    v += __int_as_float(__builtin_amdgcn_update_dpp(0, __float_as_int(v), 0x140, 0xf, 0xf, false));
    { auto r = __builtin_amdgcn_permlane16_swap(__float_as_uint(v), __float_as_uint(v), false, false); v = __uint_as_float(r[0]) + __uint_as_float(r[1]); }
    { auto r = __builtin_amdgcn_permlane32_swap(__float_as_uint(v), __float_as_uint(v), false, false); v = __uint_as_float(r[0]) + __uint_as_float(r[1]); }
    return v;
}
enum { RP_LN = 1, RP_COMBINE = 2, RP_FORGET = 4, RP_ROUTER = 8, RP_WRITE_XF = 16, RP_SRC_BF16 = 32, RP_WRITE_X8 = 64 };
template <int FLAGS>
__device__ __forceinline__ void row_phase(LAS unsigned char* lds, int chunk,
        const float* src, float* XF, bf16_t* XB, const float* gam, const float* bet,
        const float* w8, int w8ld, const float* bfg, float* LOGF,
        const bf16_t* YB, const f32x2* RG_in, const i32x2* POS_in,
        unsigned* RE, f32x2* RG, unsigned* RR, int* CNT, unsigned char* X8 = nullptr) {
    constexpr int RB = ((FLAGS & RP_COMBINE) && (FLAGS & RP_FORGET)) ? 2 : 4;
    const int tid = fresh_tid(), lane = tid & 63, wave = __builtin_amdgcn_readfirstlane(tid >> 6);
    LAS float* w8s = (LAS float*)lds;
    volatile LAS int* hist = (volatile LAS int*)(lds + MISC_OFF + 64);
    if (FLAGS & (RP_FORGET | RP_ROUTER)) {
        float wt[16];
#pragma unroll
        for (int j = 0; j < 16; ++j) { const int i = tid + 512 * j; wt[j] = w8[(size_t)(i >> 3) * w8ld + (i & 7)]; }
        __builtin_amdgcn_sched_barrier(0);
#pragma unroll
        for (int j = 0; j < 16; ++j) { const int i = tid + 512 * j; w8s[(i & 7) * 1024 + (i >> 3)] = wt[j]; }
        if (tid < 8) hist[tid] = 0;
        __syncthreads();
    }
    f32x4 gv[4], bv[4];
    if (FLAGS & RP_LN) {
#pragma unroll
        for (int j = 0; j < 4; ++j) { gv[j] = ((const f32x4*)gam)[lane + 64 * j]; bv[j] = ((const f32x4*)bet)[lane + 64 * j]; }
    }
    for (int it = 0; it < 16 / RB; ++it) {
        const int m0 = chunk * 128 + wave * 16 + it * RB;
        f32x4 v[RB][4]; u32x2 raw[RB][4]; u32x2 ya[RB][4], yb[RB][4]; f32x2 gg[RB];
        if (FLAGS & RP_COMBINE) {
            i32x2 pp[RB];
#pragma unroll
            for (int r = 0; r < RB; ++r) { gg[r] = RG_in[m0 + r]; pp[r] = POS_in[m0 + r]; }
#pragma unroll
            for (int r = 0; r < RB; ++r) { const u32x2* y0 = (const u32x2*)(YB + (size_t)pp[r].x * DM); const u32x2* y1 = (const u32x2*)(YB + (size_t)pp[r].y * DM);
#pragma unroll
                for (int j = 0; j < 4; ++j) { ya[r][j] = __builtin_nontemporal_load(y0 + lane + 64 * j); yb[r][j] = __builtin_nontemporal_load(y1 + lane + 64 * j); } }
        }
        if (FLAGS & RP_SRC_BF16) {
#pragma unroll
            for (int r = 0; r < RB; ++r)
#pragma unroll
                for (int j = 0; j < 4; ++j) raw[r][j] = __builtin_nontemporal_load((const u32x2*)((const bf16_t*)src + (size_t)(m0 + r) * DM) + lane + 64 * j);
        } else {
#pragma unroll
            for (int r = 0; r < RB; ++r)
#pragma unroll
                for (int j = 0; j < 4; ++j) v[r][j] = __builtin_nontemporal_load((const f32x4*)(src + (size_t)(m0 + r) * DM) + lane + 64 * j);
        }
        __builtin_amdgcn_sched_barrier(0);
        if (FLAGS & RP_SRC_BF16) {
#pragma unroll
            for (int r = 0; r < RB; ++r)
#pragma unroll
                for (int j = 0; j < 4; ++j) { const u32x2 w = raw[r][j]; v[r][j] = (f32x4){bf_lo(w.x), bf_hi(w.x), bf_lo(w.y), bf_hi(w.y)}; }
        }
        if (FLAGS & RP_COMBINE) {
#pragma unroll
            for (int r = 0; r < RB; ++r)
#pragma unroll
                for (int j = 0; j < 4; ++j) { const u32x2 a = ya[r][j], b = yb[r][j];
                    const f32x4 fa = {bf_lo(a.x), bf_hi(a.x), bf_lo(a.y), bf_hi(a.y)}, fb = {bf_lo(b.x), bf_hi(b.x), bf_lo(b.y), bf_hi(b.y)};
                    v[r][j] = v[r][j] * ALPHA + (fa * gg[r].x + fb * gg[r].y); }
        }
        if (FLAGS & RP_LN) {
            float mean[RB], rstd[RB];
#pragma unroll
            for (int r = 0; r < RB; ++r) { float s = 0.f;
#pragma unroll
                for (int j = 0; j < 4; ++j) s += (v[r][j].x + v[r][j].y) + (v[r][j].z + v[r][j].w);
                mean[r] = wave_sum_dpp(s) * (1.f / DM); }
#pragma unroll
            for (int r = 0; r < RB; ++r) { float s2 = 0.f;
#pragma unroll
                for (int j = 0; j < 4; ++j) { v[r][j] = v[r][j] - mean[r]; s2 += (v[r][j].x * v[r][j].x + v[r][j].y * v[r][j].y) + (v[r][j].z * v[r][j].z + v[r][j].w * v[r][j].w); }
                rstd[r] = 1.f / sqrtf(wave_sum_dpp(s2) * (1.f / DM) + LN_EPS); }
#pragma unroll
            for (int r = 0; r < RB; ++r)
#pragma unroll
                for (int j = 0; j < 4; ++j) v[r][j] = v[r][j] * rstd[r] * gv[j] + bv[j];
        }
#pragma unroll
        for (int r = 0; r < RB; ++r) {
            if (FLAGS & RP_WRITE_XF) {
#pragma unroll
                for (int j = 0; j < 4; ++j) ((f32x4*)(XF + (size_t)(m0 + r) * DM))[lane + 64 * j] = v[r][j];
            }
            u32x2* o8 = (u32x2*)(XB + (size_t)(m0 + r) * DM);
#pragma unroll
            for (int j = 0; j < 4; ++j) { u32x2 w; w.x = cvt_pk_bf16(v[r][j].x, v[r][j].y); w.y = cvt_pk_bf16(v[r][j].z, v[r][j].w); o8[lane + 64 * j] = w; }
            if (FLAGS & RP_WRITE_X8) { unsigned* o1 = (unsigned*)(X8 + (size_t)(m0 + r) * DM);
#pragma unroll
                for (int j = 0; j < 4; ++j) o1[lane + 64 * j] = pg8::pack4_fp8(v[r][j].x * S8_X, v[r][j].y * S8_X, v[r][j].z * S8_X, v[r][j].w * S8_X); }
        }
        if (FLAGS & (RP_FORGET | RP_ROUTER)) {
            float d[RB][8];
#pragma unroll
            for (int e = 0; e < 8; ++e) { f32x4 w[4];
#pragma unroll
                for (int j = 0; j < 4; ++j) w[j] = ((const LAS f32x4*)(w8s + e * 1024))[lane + 64 * j];
#pragma unroll
                for (int r = 0; r < RB; ++r) { float a = 0.f;
#pragma unroll
                    for (int j = 0; j < 4; ++j) a += (v[r][j].x * w[j].x + v[r][j].y * w[j].y) + (v[r][j].z * w[j].z + v[r][j].w * w[j].w);
                    d[r][e] = wave_sum_dpp(a); } }
#pragma unroll
            for (int r = 0; r < RB; ++r) {
                const int m = m0 + r;
                if (FLAGS & RP_FORGET) {
                    float lg[8];
#pragma unroll
                    for (int e = 0; e < 8; ++e) { const float z = d[r][e] + bfg[e]; lg[e] = fminf(z, 0.f) - 0.6931471805599453f * __builtin_amdgcn_logf(1.0f + __builtin_amdgcn_exp2f(-fabsf(z) * LOG2E)); }
                    if (lane == 0) { f32x4* dst = (f32x4*)(LOGF + (size_t)m * 8); dst[0] = (f32x4){lg[0], lg[1], lg[2], lg[3]}; dst[1] = (f32x4){lg[4], lg[5], lg[6], lg[7]}; }
                }
                if (FLAGS & RP_ROUTER) {
                    float v0 = -INFINITY, v1 = -INFINITY; int i0 = 0, i1 = 0;
#pragma unroll
                    for (int e = 0; e < 8; ++e) { const float x = d[r][e];
                        if (x > v0) { v1 = v0; i1 = i0; v0 = x; i0 = e; } else if (x > v1) { v1 = x; i1 = e; } }
                    if (lane == 0) {
                        const float ex = __builtin_amdgcn_exp2f((v1 - v0) * LOG2E), inv = 1.f / (1.f + ex);
                        const int r0 = __hip_atomic_fetch_add((LAS int*)(lds + MISC_OFF + 64) + i0, 1, __ATOMIC_RELAXED, __HIP_MEMORY_SCOPE_WORKGROUP), r1 = __hip_atomic_fetch_add((LAS int*)(lds + MISC_OFF + 64) + i1, 1, __ATOMIC_RELAXED, __HIP_MEMORY_SCOPE_WORKGROUP);
                        RE[m] = (unsigned)i0 | ((unsigned)i1 << 8); RR[m] = (unsigned)r0 | ((unsigned)r1 << 16); RG[m] = (f32x2){inv, ex * inv};
                    }
                }
            }
        }
    }
    if (FLAGS & RP_ROUTER) { __syncthreads(); if (tid < 8) CNT[chunk * 8 + tid] = hist[tid]; }
    __syncthreads();
}

__device__ __forceinline__ void fox_scan(LAS unsigned char* lds, int bh, const float* LOGF, float* FL) {
    const int tid = fresh_tid(), lane = tid & 63, wave = __builtin_amdgcn_readfirstlane(tid >> 6);
    LAS float* wtot = (LAS float*)lds;
    const int b = bh >> 3, h = bh & 7;
    float x[8]; float run = 0.f;
#pragma unroll
    for (int i = 0; i < 8; ++i) { run += LOGF[((size_t)b * SEQ + 8 * tid + i) * 8 + h]; x[i] = run; }
    float inc = run;
#pragma unroll
    for (int o = 1; o < 64; o <<= 1) { const float y = __int_as_float(__builtin_amdgcn_ds_bpermute((lane - o) << 2, __float_as_int(inc))); if (lane >= o) inc += y; }
    if (lane == 63) wtot[wave] = inc;
    __syncthreads();
    float pre = inc - run;
#pragma unroll
    for (int w = 0; w < 8; ++w) { const float t = wtot[w]; if (w < wave) pre += t; }
    f32x4 o0 = {(pre + x[0]) * LOG2E, (pre + x[1]) * LOG2E, (pre + x[2]) * LOG2E, (pre + x[3]) * LOG2E}, o1 = {(pre + x[4]) * LOG2E, (pre + x[5]) * LOG2E, (pre + x[6]) * LOG2E, (pre + x[7]) * LOG2E};
    f32x4* dst = (f32x4*)(FL + (size_t)bh * SEQ + 8 * tid); dst[0] = o0; dst[1] = o1;
    __syncthreads();
}

__device__ __forceinline__ void kmean_unit(LAS unsigned char* lds, int c, const bf16_t* Kp  , float* KMEAN) {
    const int tid = fresh_tid(), lane = tid & 63, wave = __builtin_amdgcn_readfirstlane(tid >> 6);
    const int bn = c >> 1, col0 = 512 * (c & 1);
    const bf16_t* p = Kp + ((size_t)bn * 256 + 32 * wave) * 3072 + col0 + 8 * lane;
    float a[8];
#pragma unroll
    for (int j = 0; j < 8; ++j) a[j] = 0.f;
    u32x4 kw[32];
#pragma unroll
    for (int r = 0; r < 32; ++r) kw[r] = *(const u32x4*)(p + (size_t)r * 3072);
    __builtin_amdgcn_sched_barrier(0);
#pragma unroll
    for (int r = 0; r < 32; ++r) { const u32x4 w = kw[r];
        a[0] += bf_lo(w.x); a[1] += bf_hi(w.x); a[2] += bf_lo(w.y); a[3] += bf_hi(w.y); a[4] += bf_lo(w.z); a[5] += bf_hi(w.z); a[6] += bf_lo(w.w); a[7] += bf_hi(w.w); }
    LAS float* red = (LAS float*)lds;
    *(LAS f32x4*)(red + wave * 512 + 8 * lane) = (f32x4){a[0], a[1], a[2], a[3]}; *(LAS f32x4*)(red + wave * 512 + 8 * lane + 4) = (f32x4){a[4], a[5], a[6], a[7]};
    __syncthreads();
    float s = 0.f;
#pragma unroll
    for (int w = 0; w < 8; ++w) s += red[w * 512 + tid];
    KMEAN[(size_t)bn * 1024 + col0 + tid] = s * (1.f / 256.f);
    __syncthreads();
}

__device__ __forceinline__ void moe_sort(LAS unsigned char* lds, int chunk, const int* CNT, const unsigned* RE, const unsigned* RR, const bf16_t* XB, unsigned char* XS8, i32x2* POS, int* PB) {
    const int tid = fresh_tid(), lane = tid & 63, wave = __builtin_amdgcn_readfirstlane(tid >> 6);
    LAS int* tbl = (LAS int*)lds;
    LAS int* tot = (LAS int*)(lds + 8192);
    for (int i = tid; i < 2048; i += 512) tbl[i] = CNT[i];
    __syncthreads();
    { const int e = wave; float t = 0.f, before = 0.f;
#pragma unroll
      for (int j = 0; j < 4; ++j) { const int c = 4 * lane + j; const float v = (float)tbl[c * 8 + e]; t += v; before += (c < chunk) ? v : 0.f; }
      t = wave_sum_dpp(t); before = wave_sum_dpp(before);
      if (lane == 0) { tot[e] = (int)t; tot[8 + e] = (int)before; } }
    __syncthreads();
    if (tid == 0) { int pb = 0; for (int e = 0; e < 8; ++e) { tot[16 + e] = pb * 256 + tot[8 + e]; pb += (tot[e] + 255) >> 8; tot[24 + e] = pb; } if (chunk == 0) PB[8] = pb; }
    __syncthreads();
    if (chunk == 0 && tid < tot[31]) { int e = 0;
#pragma unroll
        for (int k = 0; k < 7; ++k) e += (tid >= tot[24 + k]) ? 1 : 0;
        PB[16 + tid] = e; }
#pragma unroll 1
    for (int it = 0; it < 4; ++it) {
        const int m0 = chunk * 128 + wave * 16 + it * 4;
        unsigned e[4], r[4]; u32x2 xw[4][4];
#pragma unroll
        for (int q = 0; q < 4; ++q) { e[q] = RE[m0 + q]; r[q] = RR[m0 + q];
#pragma unroll
            for (int j = 0; j < 4; ++j) xw[q][j] = ((const u32x2*)(XB + (size_t)(m0 + q) * DM))[lane + 64 * j]; }
#pragma unroll
        for (int q = 0; q < 4; ++q) {
            const int p0 = tot[16 + (e[q] & 0xff)] + (int)(r[q] & 0xffff), p1 = tot[16 + (e[q] >> 8)] + (int)(r[q] >> 16);
            unsigned* d0 = (unsigned*)(XS8 + (size_t)p0 * DM); unsigned* d1 = (unsigned*)(XS8 + (size_t)p1 * DM);
#pragma unroll
            for (int j = 0; j < 4; ++j) { const u32x2 x = xw[q][j]; const unsigned w = pg8::pack4_fp8(bf_lo(x.x) * S8_X, bf_hi(x.x) * S8_X, bf_lo(x.y) * S8_X, bf_hi(x.y) * S8_X); d0[lane + 64 * j] = w; d1[lane + 64 * j] = w; }
            if (lane == 0) POS[m0 + q] = (i32x2){p0, p1};
        }
    }
    __syncthreads();
}

constexpr float AT_THR = 6.0f;
constexpr float AT_PRUNE = 48.0f;
__device__ __forceinline__ float half_sum(float v) { auto r = __builtin_amdgcn_permlane32_swap(__float_as_uint(v), __float_as_uint(v), false, false); return __uint_as_float(r[0]) + __uint_as_float(r[1]); }
__device__ __forceinline__ float half_max(float v) { auto r = __builtin_amdgcn_permlane32_swap(__float_as_uint(v), __float_as_uint(v), false, false); return fmaxf(__uint_as_float(r[0]), __uint_as_float(r[1])); }
__device__ __forceinline__ int crow(int r, int hi) { return (r & 3) + 8 * (r >> 2) + 4 * hi; }
__device__ __forceinline__ s16x4 vtr(const LAS unsigned char* p) { return __builtin_bit_cast(s16x4, __builtin_amdgcn_ds_read_tr16_b64_v4i16((LAS s16x4*)p)); }

constexpr int PL_PITCH = 272;
template <int W>
__device__ __forceinline__ void pool_mix(LAS unsigned char* lds, int tid, const bf16_t* up, int tseq0) {
    const int cp = tid & 63, i0 = 32 * (tid >> 6);
    const bf16_t* src = up + 2 * cp;
    unsigned uu[32 + W - 1];
#pragma unroll
    for (int k = 0; k < 32 + W - 1; ++k) { const int i = i0 - (W - 1) + k; uu[k] = (tseq0 + i >= 0) ? *(const unsigned*)(src + (long)i * 2048) : 0u; }
    float s0 = 0.f, s1 = 0.f;
#pragma unroll
    for (int k = 0; k < W - 1; ++k) { s0 += bf_lo(uu[k]); s1 += bf_hi(uu[k]); }
#pragma unroll
    for (int r = 0; r < 32; ++r) { const unsigned x = uu[r + W - 1]; const float a = bf_lo(x), b = bf_hi(x); s0 += a; s1 += b;
        const int t = tseq0 + i0 + r; const float icnt = __builtin_amdgcn_rcpf((float)((t + 1 < W) ? (t + 1) : W));
        *(LAS unsigned*)(lds + (i0 + r) * PL_PITCH + cp * 4) = cvt_pk_bf16(s0 * icnt - a, s1 * icnt - b);
        s0 -= bf_lo(uu[r]); s1 -= bf_hi(uu[r]); }
}
__device__ __forceinline__ void pool_unit(LAS unsigned char* lds, int pm, int g, const bf16_t* HC  , const bf16_t* WP  , bf16_t* CAT  ) {
    const int tid = fresh_tid(), lane = tid & 63, wv = __builtin_amdgcn_readfirstlane(tid >> 6), fr = lane & 15, fq = lane >> 4;
    const int row0 = pm * 256, tseq0 = row0 & (SEQ - 1);
    { const bf16_t* up = HC + (size_t)row0 * 2048 + 1536 + 128 * g;
      if (g == 0) pool_mix<2>(lds, tid, up, tseq0); else if (g == 1) pool_mix<4>(lds, tid, up, tseq0); else if (g == 2) pool_mix<8>(lds, tid, up, tseq0); else pool_mix<16>(lds, tid, up, tseq0); }
    const bf16_t* wp = WP + (size_t)g * 16384;
    bf16x8 bw[4][8];
#pragma unroll
    for (int ks = 0; ks < 4; ++ks)
#pragma unroll
        for (int n = 0; n < 8; ++n) bw[ks][n] = *(const bf16x8*)(wp + (16 * n + fr) * 128 + 32 * ks + 8 * fq);
    __builtin_amdgcn_sched_barrier(0);
    __syncthreads();
    f32x4 acc[2][8];
#pragma unroll
    for (int m = 0; m < 2; ++m)
#pragma unroll
        for (int n = 0; n < 8; ++n) acc[m][n] = (f32x4){0.f, 0.f, 0.f, 0.f};
#pragma unroll
    for (int ks = 0; ks < 4; ++ks) {
        bf16x8 a[2];
#pragma unroll
        for (int m = 0; m < 2; ++m) a[m] = *(const LAS bf16x8*)(lds + (32 * wv + 16 * m + fr) * PL_PITCH + (32 * ks + 8 * fq) * 2);
#pragma unroll
        for (int n = 0; n < 8; ++n) {
            const bf16x8 bfrag = bw[ks][n];
#pragma unroll
            for (int m = 0; m < 2; ++m) acc[m][n] = __builtin_amdgcn_mfma_f32_16x16x32_bf16(bfrag, a[m], acc[m][n], 0, 0, 0); }
    }
#pragma unroll
    for (int m = 0; m < 2; ++m) { bf16_t* orow = CAT + (size_t)(row0 + 32 * wv + 16 * m + fr) * 1024 + 512 + 128 * g + 4 * fq;
#pragma unroll
        for (int n = 0; n < 8; ++n) { u32x2 o; o.x = cvt_pk_bf16(acc[m][n][0], acc[m][n][1]); o.y = cvt_pk_bf16(acc[m][n][2], acc[m][n][3]); *(u32x2*)(orow + 16 * n) = o; } }
    __syncthreads();
}

constexpr int MB_CAPR = 5888;
constexpr int MB_KB = 0, MB_VB = 32768, MB_WS = 65536, MB_KM = 73728, MB_CNT = 77824, MB_LIST = 78080, MB_PK = 90112, MB_END = MB_PK + 2304 * 3 * 4;
static_assert(MB_LIST + MB_CAPR * 2 <= MB_PK && MB_END <= RING_BYTES, "MoBA LDS map");

__device__ __forceinline__ void moba_issue_block(u32x4 (&kr)[4], u32x4 (&vr)[4], int lane, int wid, const bf16_t* Kblk, const bf16_t* Vblk, int pitch) {
    const bf16_t* ksrc = Kblk + (size_t)lane * pitch + wid * 8;
    const bf16_t* vsrc = Vblk + (size_t)(16 * (wid & 3) + (lane >> 2)) * pitch + (wid >> 2) * 32 + (lane & 3) * 8;
#pragma unroll
    for (int j = 0; j < 4; ++j) { kr[j] = *(const u32x4*)(ksrc + (size_t)j * 64 * pitch); vr[j] = *(const u32x4*)(vsrc + (size_t)j * 64 * pitch); }
}
__device__ __forceinline__ void moba_commit_block(LAS unsigned char* lds, const u32x4 (&kr)[4], const u32x4 (&vr)[4], int lane, int wid) {
    const int stoff = wid * 1024 + lane * 16;
#pragma unroll
    for (int j = 0; j < 4; ++j) { *(LAS u32x4*)(lds + MB_KB + j * 8192 + stoff) = kr[j]; *(LAS u32x4*)(lds + MB_VB + j * 8192 + stoff) = vr[j]; }
}
template <bool CAUSAL>
__device__ __forceinline__ void moba_block(LAS unsigned char* lds, int lane, int wid, int r32, int hi, const bf16x8 (&qr)[4], int qrel, int qmax, float& mhat, float& lsum, f32x16& o0, f32x16& o1) {
    LAS float* wsf = (LAS float*)(lds + MB_WS) + wid * 256;
    const int kfo = hi * 1024 + r32 * 16;
    const int vfo = ((lane >> 4) & 1) * 32 + (lane & 3) * 8 + (4 * hi + ((lane & 15) >> 2)) * 64;
#pragma unroll 1
    for (int t = 0; t < 4; ++t) {
        if (CAUSAL) { if (64 * t > qmax) break; }
        {
            const LAS unsigned char* kb_ = lds + MB_KB + t * 8192 + kfo;
            f32x16 p0 = {}, p1 = {};
bf16x8 kf[8];
#pragma unroll
            for (int d0 = 0; d0 < 4; ++d0) { kf[2 * d0] = *(const LAS bf16x8*)(kb_ + d0 * 2048); kf[2 * d0 + 1] = *(const LAS bf16x8*)(kb_ + d0 * 2048 + 512); }
            __builtin_amdgcn_sched_barrier(0);
#pragma unroll
            for (int d0 = 0; d0 < 4; ++d0) { p0 = __builtin_amdgcn_mfma_f32_32x32x16_bf16(kf[2 * d0], qr[d0], p0, 0, 0, 0); p1 = __builtin_amdgcn_mfma_f32_32x32x16_bf16(kf[2 * d0 + 1], qr[d0], p1, 0, 0, 0); }
            s16x4 vlo[8], vhi[8];
            { const LAS unsigned char* vq_ = (lds + MB_VB + t * 8192 + vfo);
#pragma unroll
              for (int i = 0; i < 8; ++i) { vlo[i] = vtr(vq_ + (i & 1) * 4096 + (i >> 1) * 1024); vhi[i] = vtr(vq_ + (i & 1) * 4096 + (i >> 1) * 1024 + 512); } }
            __builtin_amdgcn_sched_barrier(0);
#pragma unroll
            for (int r = 0; r < 16; ++r) { p0[r] -= mhat; p1[r] -= mhat; }
            if (CAUSAL) { const int kbase = 64 * t + 4 * hi;
#pragma unroll
                for (int r = 0; r < 16; ++r) { const int kv = kbase + (r & 3) + 8 * (r >> 2); if (kv > qrel) p0[r] = -INFINITY; if (kv + 32 > qrel) p1[r] = -INFINITY; } }
#define MX3(a_, b_, c_) __builtin_fmaxf(__builtin_fmaxf((a_), (b_)), (c_))
            float ra = MX3(p0[0], p0[1], p1[0]), rb = MX3(p0[2], p0[3], p1[1]); ra = MX3(ra, p1[2], p1[3]);
#pragma unroll
            for (int r = 4; r < 16; r += 4) { ra = MX3(ra, p0[r], p0[r + 1]); rb = MX3(rb, p0[r + 2], p0[r + 3]); ra = MX3(ra, p1[r], p1[r + 1]); rb = MX3(rb, p1[r + 2], p1[r + 3]); }
#undef MX3
            const float rm = half_max(fmaxf(ra, rb));
            const bool mv = rm > AT_THR;
            if (__any(mv)) {
                const float dl = mv ? rm : 0.f, al = __builtin_amdgcn_exp2f(-dl); mhat += dl; lsum *= al;
#pragma unroll
                for (int r = 0; r < 16; ++r) { p0[r] -= dl; p1[r] -= dl; }
                if (hi == 0) wsf[r32] = al;
#pragma unroll
                for (int g = 0; g < 4; ++g) { const f32x4 a4 = *(const LAS f32x4*)(wsf + 8 * g + 4 * hi);
                    o0[4 * g + 0] *= a4.x; o0[4 * g + 1] *= a4.y; o0[4 * g + 2] *= a4.z; o0[4 * g + 3] *= a4.w; o1[4 * g + 0] *= a4.x; o1[4 * g + 1] *= a4.y; o1[4 * g + 2] *= a4.z; o1[4 * g + 3] *= a4.w; }
            }
            float ps = 0.f;
#pragma unroll
            for (int r = 0; r < 16; ++r) { p0[r] = __builtin_amdgcn_exp2f(p0[r]); p1[r] = __builtin_amdgcn_exp2f(p1[r]); ps += p0[r] + p1[r]; }
            lsum += ps;
            u32x4 pw0, pw1, pw2, pw3;
            pw0.x = cvt_pk_bf16(p0[0], p0[1]); pw0.y = cvt_pk_bf16(p0[2], p0[3]); pw0.z = cvt_pk_bf16(p0[4], p0[5]); pw0.w = cvt_pk_bf16(p0[6], p0[7]);
            pw1.x = cvt_pk_bf16(p0[8], p0[9]); pw1.y = cvt_pk_bf16(p0[10], p0[11]); pw1.z = cvt_pk_bf16(p0[12], p0[13]); pw1.w = cvt_pk_bf16(p0[14], p0[15]);
            pw2.x = cvt_pk_bf16(p1[0], p1[1]); pw2.y = cvt_pk_bf16(p1[2], p1[3]); pw2.z = cvt_pk_bf16(p1[4], p1[5]); pw2.w = cvt_pk_bf16(p1[6], p1[7]);
            pw3.x = cvt_pk_bf16(p1[8], p1[9]); pw3.y = cvt_pk_bf16(p1[10], p1[11]); pw3.z = cvt_pk_bf16(p1[12], p1[13]); pw3.w = cvt_pk_bf16(p1[14], p1[15]);
            __builtin_amdgcn_sched_barrier(0);
#define PV_STEP(OACC, I, PW) do { const bf16x8 vf_ = {vlo[I][0], vlo[I][1], vlo[I][2], vlo[I][3], vhi[I][0], vhi[I][1], vhi[I][2], vhi[I][3]}; \
                OACC = __builtin_amdgcn_mfma_f32_32x32x16_bf16(__builtin_bit_cast(bf16x8, PW), vf_, OACC, 0, 0, 0); } while (0)
            PV_STEP(o0, 0, pw0); PV_STEP(o1, 1, pw0); PV_STEP(o0, 2, pw1); PV_STEP(o1, 3, pw1);
            PV_STEP(o0, 4, pw2); PV_STEP(o1, 5, pw2); PV_STEP(o0, 6, pw3); PV_STEP(o1, 7, pw3);
#undef PV_STEP
        }
    }
}

__device__ __forceinline__ void moba_part(LAS unsigned char* lds, int wg, const bf16_t* Qp, const bf16_t* Kp, const bf16_t* Vp, int pitch, bf16_t* Op, int opitch,
                                          const float* KMEAN, bf16_t* PART, f32x2* ML) {
    const int tid = fresh_tid(), lane = tid & 63, r32 = lane & 31, hi = lane >> 5; const int wid = __builtin_amdgcn_readfirstlane(tid >> 6);
    const int bh = wg >> 1, part = wg & 1, b = bh >> 4, h = bh & 15;
    const int qb_lo = part ? 9 : 0, qb_hi = part ? 16 : 9, nq = (qb_hi - qb_lo) * 256;
    const size_t rowbase = (size_t)b * SEQ; const size_t pbase = (size_t)wg * MB_CAPR;
    LAS float* km = (LAS float*)(lds + MB_KM);
    LAS int* cnt = (LAS int*)(lds + MB_CNT); LAS int* off = cnt + 16;
    LAS unsigned short* LIST = (LAS unsigned short*)(lds + MB_LIST);
    LAS unsigned* PK = (LAS unsigned*)(lds + MB_PK);
    LAS float* wsf = (LAS float*)(lds + MB_WS) + wid * 256;
    bf16_t* POWN = (bf16_t*)(ML + (size_t)4 * 1024 * 1024) + (size_t)wg * 2304 * 64;
    f32x2* MLO = ML + (size_t)256 * MB_CAPR + (size_t)wg * 2304;
    for (int i = tid; i < 16 * 64; i += 512) km[i] = KMEAN[((size_t)b * 16 + (i >> 6)) * 1024 + h * 64 + (i & 63)];
    if (tid < 16) cnt[tid] = 0;
    __syncthreads();
#pragma unroll 1
    for (int qb = qb_lo; qb < qb_hi; ++qb) {
        const bf16_t* Qw = Qp + (rowbase + qb * 256 + wid * 32 + r32) * pitch + h * 64;
        bf16x8 qr[4];
#pragma unroll
        for (int d0 = 0; d0 < 4; ++d0) qr[d0] = *(const bf16x8*)(Qw + d0 * 16 + hi * 8);
        float qf[32];
#pragma unroll
        for (int d0 = 0; d0 < 4; ++d0)
#pragma unroll
            for (int j = 0; j < 8; ++j) qf[d0 * 8 + j] = __uint_as_float((unsigned)(unsigned short)qr[d0][j] << 16);
        float v1 = -INFINITY, v2 = -INFINITY, v3 = -INFINITY; int i1 = 0, i2 = 1, i3 = 2;
        if (qb > 3) {
            for (int n = 0; n < qb; ++n) {
                float part_ = 0.f;
#pragma unroll
                for (int d0 = 0; d0 < 4; ++d0) { const f32x4 ka = *(const LAS f32x4*)(km + n * 64 + d0 * 16 + hi * 8), kb = *(const LAS f32x4*)(km + n * 64 + d0 * 16 + hi * 8 + 4);
                    part_ += (qf[d0 * 8 + 0] * ka.x + qf[d0 * 8 + 1] * ka.y) + (qf[d0 * 8 + 2] * ka.z + qf[d0 * 8 + 3] * ka.w) + (qf[d0 * 8 + 4] * kb.x + qf[d0 * 8 + 5] * kb.y) + (qf[d0 * 8 + 6] * kb.z + qf[d0 * 8 + 7] * kb.w); }
                const float g = half_sum(part_);
                if (g > v1) { v3 = v2; i3 = i2; v2 = v1; i2 = i1; v1 = g; i1 = n; } else if (g > v2) { v3 = v2; i3 = i2; v2 = g; i2 = n; } else if (g > v3) { v3 = g; i3 = n; }
            }
        }
        const int npick = qb < 3 ? qb : 3;
        if (hi == 0) { const int tl = (qb - qb_lo) * 256 + wid * 32 + r32;
            unsigned e0 = 0xffffffffu, e1 = 0xffffffffu, e2 = 0xffffffffu;
            if (npick > 0) e0 = ((unsigned)i1 << 16) | (unsigned)__hip_atomic_fetch_add(cnt + i1, 1, __ATOMIC_RELAXED, __HIP_MEMORY_SCOPE_WORKGROUP);
            if (npick > 1) e1 = ((unsigned)i2 << 16) | (unsigned)__hip_atomic_fetch_add(cnt + i2, 1, __ATOMIC_RELAXED, __HIP_MEMORY_SCOPE_WORKGROUP);
            if (npick > 2) e2 = ((unsigned)i3 << 16) | (unsigned)__hip_atomic_fetch_add(cnt + i3, 1, __ATOMIC_RELAXED, __HIP_MEMORY_SCOPE_WORKGROUP);
            PK[tl * 3 + 0] = e0; PK[tl * 3 + 1] = e1; PK[tl * 3 + 2] = e2; }
    }
    __syncthreads();
    if (tid == 0) { int run = 0; for (int n = 0; n < 16; ++n) { off[n] = run; run += (cnt[n] + 31) & ~31; } off[16] = run; }
    __syncthreads();
    for (int tl = tid; tl < nq; tl += 512) {
#pragma unroll
        for (int s = 0; s < 3; ++s) { const unsigned e = PK[tl * 3 + s];
            if (e != 0xffffffffu) { const int row = off[e >> 16] + (int)(e & 0xffffu); LIST[row] = (unsigned short)(qb_lo * 256 + tl); PK[tl * 3 + s] = (unsigned)row; } }
    }
    if (tid < 16) { for (int r = off[tid] + cnt[tid]; r < off[tid + 1]; ++r) LIST[r] = (unsigned short)(qb_lo * 256); }
    __syncthreads();
#define MB_STORE_PARTIAL(DST, MLP) do { const float ltot_ = half_sum(lsum); \
        if (hi == 0) { wsf[r32] = 1.0f / ltot_; (MLP)[r32] = (f32x2){mhat, ltot_}; } \
        _Pragma("unroll") for (int g = 0; g < 4; ++g) { const f32x4 a4 = *(const LAS f32x4*)(wsf + 8 * g + 4 * hi); \
            _Pragma("unroll") for (int j = 0; j < 4; ++j) { const int r = 4 * g + j; const float inv_ = (j == 0) ? a4.x : (j == 1) ? a4.y : (j == 2) ? a4.z : a4.w; \
                ((unsigned*)(DST))[(size_t)crow(r, hi) * 32 + r32] = cvt_pk_bf16(o0[r] * inv_, o1[r] * inv_); } } } while (0)
    {
        u32x4 kr[4], vr[4];
#define MB_WORK(n_) ((off[(n_) + 1] > off[(n_)]) || ((n_) >= qb_lo && (n_) < qb_hi))
        int n = 0; while (n < 16 && !MB_WORK(n)) ++n;
        n = __builtin_amdgcn_readfirstlane(n);
        if (n < 16) moba_issue_block(kr, vr, lane, wid, Kp + (rowbase + n * 256) * pitch + h * 64, Vp + (rowbase + n * 256) * pitch + h * 64, pitch);
#pragma unroll 1
        while (n < 16) {
            const int o_n = __builtin_amdgcn_readfirstlane(off[n]), len = __builtin_amdgcn_readfirstlane(off[n + 1]) - o_n;
            const int G = len >> 5, T = G + ((n >= qb_lo && n < qb_hi) ? 8 : 0);
#define MB_TASK_ROW(j_) (((j_) < G) ? (int)LIST[o_n + 32 * (j_) + r32] : (n * 256 + (7 - ((j_) - G)) * 32 + r32))
            bf16x8 qr[4];
            if (wid < T) { const int t = MB_TASK_ROW(wid); const bf16_t* Qw = Qp + (rowbase + t) * pitch + h * 64;
#pragma unroll
                for (int d0 = 0; d0 < 4; ++d0) qr[d0] = *(const bf16x8*)(Qw + d0 * 16 + hi * 8); }
            __syncthreads();
            moba_commit_block(lds, kr, vr, lane, wid);
            __syncthreads();
            int nn = n + 1; while (nn < 16 && !MB_WORK(nn)) ++nn;
            nn = __builtin_amdgcn_readfirstlane(nn);
            if (nn < 16) moba_issue_block(kr, vr, lane, wid, Kp + (rowbase + nn * 256) * pitch + h * 64, Vp + (rowbase + nn * 256) * pitch + h * 64, pitch);
#pragma unroll 1
            for (int j = wid; j < T; j += 8) {
                bf16x8 qn[4];
                if (j + 8 < T) { const int t = MB_TASK_ROW(j + 8); const bf16_t* Qw = Qp + (rowbase + t) * pitch + h * 64;
#pragma unroll
                    for (int d0 = 0; d0 < 4; ++d0) qn[d0] = *(const bf16x8*)(Qw + d0 * 16 + hi * 8); }
                float mhat = 0.f, lsum = 0.f; f32x16 o0 = {}, o1 = {};
                if (j < G) {
                    moba_block<false>(lds, lane, wid, r32, hi, qr, 0, 0, mhat, lsum, o0, o1);
                    bf16_t* pdst = PART + (pbase + o_n + 32 * j) * 64; f32x2* mdst = ML + pbase + o_n + 32 * j;
                    MB_STORE_PARTIAL(pdst, mdst);
                } else { const int og = 7 - (j - G);
                    moba_block<true>(lds, lane, wid, r32, hi, qr, og * 32 + r32, og * 32 + 31, mhat, lsum, o0, o1);
                    bf16_t* pdst = POWN + ((size_t)(n - qb_lo) * 256 + og * 32) * 64; f32x2* mdst = MLO + (n - qb_lo) * 256 + og * 32;
                    MB_STORE_PARTIAL(pdst, mdst);
                }
                if (j + 8 < T) {
#pragma unroll
                    for (int d0 = 0; d0 < 4; ++d0) qr[d0] = qn[d0]; }
            }
            n = nn;
        }
#undef MB_TASK_ROW
#undef MB_WORK
    }
#undef MB_STORE_PARTIAL
    __syncthreads();
#pragma unroll 2
    for (int i = tid; i < nq * 8; i += 512) {
        const int tl = i >> 3, c = i & 7;
        const unsigned r1 = PK[tl * 3 + 0], r2 = PK[tl * 3 + 1], r3 = PK[tl * 3 + 2];
        const f32x2 so = MLO[tl];
        f32x2 s1 = {-1e30f, 0.f}, s2 = {-1e30f, 0.f}, s3 = {-1e30f, 0.f};
        if (r1 != 0xffffffffu) s1 = ML[pbase + r1]; if (r2 != 0xffffffffu) s2 = ML[pbase + r2]; if (r3 != 0xffffffffu) s3 = ML[pbase + r3];
        const float M = fmaxf(fmaxf(so.x, s1.x), fmaxf(s2.x, s3.x));
        const float wo = __builtin_amdgcn_exp2f(so.x - M) * so.y, w1 = __builtin_amdgcn_exp2f(s1.x - M) * s1.y, w2 = __builtin_amdgcn_exp2f(s2.x - M) * s2.y, w3 = __builtin_amdgcn_exp2f(s3.x - M) * s3.y;
        const float inv = 1.0f / (wo + w1 + w2 + w3);
        const u32x4 zero4 = {0u, 0u, 0u, 0u};
        const u32x4 xo = *(const u32x4*)(POWN + (size_t)tl * 64 + c * 8);
        const u32x4 x1 = (r1 != 0xffffffffu) ? *(const u32x4*)(PART + (pbase + r1) * 64 + c * 8) : zero4;
        const u32x4 x2 = (r2 != 0xffffffffu) ? *(const u32x4*)(PART + (pbase + r2) * 64 + c * 8) : zero4;
        const u32x4 x3 = (r3 != 0xffffffffu) ? *(const u32x4*)(PART + (pbase + r3) * 64 + c * 8) : zero4;
        const float fo = wo * inv, f1 = w1 * inv, f2 = w2 * inv, f3 = w3 * inv;
#define MB_LO(k) (fo * bf_lo(xo[k]) + (f1 * bf_lo(x1[k]) + f2 * bf_lo(x2[k]) + f3 * bf_lo(x3[k])))
#define MB_HI(k) (fo * bf_hi(xo[k]) + (f1 * bf_hi(x1[k]) + f2 * bf_hi(x2[k]) + f3 * bf_hi(x3[k])))
        bf16_t* orow = Op + (rowbase + qb_lo * 256 + tl) * opitch + h * 64 + c * 4;
        *(u32x2*)orow = (u32x2){cvt_pk_bf16(MB_LO(0), MB_LO(1)), cvt_pk_bf16(MB_LO(2), MB_LO(3))};
        *(u32x2*)(orow + 32) = (u32x2){cvt_pk_bf16(MB_HI(0), MB_HI(1)), cvt_pk_bf16(MB_HI(2), MB_HI(3))};
#undef MB_LO
#undef MB_HI
    }
    __syncthreads();
}

constexpr int FX_FB = 65536 + 8192;
__device__ __forceinline__ void fox_unit(LAS unsigned char* lds, const bf16_t* Qp, const bf16_t* Kp, const bf16_t* Vp, int pitch, bf16_t* Op, int opitch, int b, int h, int qb, const float* FLbh) {
    const int tid = fresh_tid(), lane = tid & 63, r32 = lane & 31, hi = lane >> 5; const int wid = __builtin_amdgcn_readfirstlane(tid >> 6);
    const size_t rowbase = (size_t)b * SEQ; const int q0 = qb * 256;
    const bf16_t* Qw = Qp + (rowbase + q0 + wid * 32 + r32) * pitch + h * 64;
    bf16x8 qr[4];
#pragma unroll
    for (int d0 = 0; d0 < 4; ++d0) qr[d0] = *(const bf16x8*)(Qw + d0 * 16 + hi * 8);
    const int NT = 4 * (qb + 1);
    const float flq0 = FLbh[q0], flw0 = FLbh[q0 + wid * 32];
    int t0u, t0w;
    { const bool live = lane < NT - 4; const float fe = live ? FLbh[64 * lane + 63] : 0.f;
      t0u = __builtin_popcountll(__ballot(live && (flq0 - fe < -AT_PRUNE))); t0w = __builtin_popcountll(__ballot(live && (flw0 - fe < -AT_PRUNE))); }
    t0u = __builtin_amdgcn_readfirstlane(t0u); t0w = __builtin_amdgcn_readfirstlane(t0w);
    const int kb0 = t0u >> 2;
    float mhat = -1e30f, lsum = 0.f; f32x16 o0 = {}, o1 = {};
    LAS float* wsf = (LAS float*)(lds + MB_WS) + wid * 256;
    LAS float* fbl = (LAS float*)(lds + FX_FB);
    const int kfo = hi * 1024 + r32 * 16;
    const int vfo = ((lane >> 4) & 1) * 32 + (lane & 3) * 8 + (4 * hi + ((lane & 15) >> 2)) * 64;
    const int qrel = wid * 32 + r32;
    const bf16_t* Kh = Kp + rowbase * pitch + h * 64; const bf16_t* Vh = Vp + rowbase * pitch + h * 64;
    u32x4 kr[4], vr[4]; float fr_ = 0.f;
    moba_issue_block(kr, vr, lane, wid, Kh + (size_t)kb0 * 256 * pitch, Vh + (size_t)kb0 * 256 * pitch, pitch);
    if (tid < 256) fr_ = flq0 - FLbh[kb0 * 256 + tid];
#pragma unroll 1
    for (int kb = kb0; kb <= qb; ++kb) {
        __syncthreads();
        moba_commit_block(lds, kr, vr, lane, wid);
        if (tid < 256) fbl[tid] = fr_;
        __syncthreads();
        if (kb < qb) { moba_issue_block(kr, vr, lane, wid, Kh + (size_t)(kb + 1) * 256 * pitch, Vh + (size_t)(kb + 1) * 256 * pitch, pitch); if (tid < 256) fr_ = flq0 - FLbh[(kb + 1) * 256 + tid]; }
        const bool diag = (kb == qb);
#pragma unroll 1
        for (int t = 0; t < 4; ++t) {
            if (kb * 4 + t < t0w) continue;
            if (diag && 64 * t > wid * 32 + 31) break;
            const LAS unsigned char* kb_ = lds + MB_KB + t * 8192 + kfo;
            f32x16 p0 = {}, p1 = {};
            bf16x8 kf[8];
#pragma unroll
            for (int d0 = 0; d0 < 4; ++d0) { kf[2 * d0] = *(const LAS bf16x8*)(kb_ + d0 * 2048); kf[2 * d0 + 1] = *(const LAS bf16x8*)(kb_ + d0 * 2048 + 512); }
            __builtin_amdgcn_sched_barrier(0);
#pragma unroll
            for (int d0 = 0; d0 < 4; ++d0) { p0 = __builtin_amdgcn_mfma_f32_32x32x16_bf16(kf[2 * d0], qr[d0], p0, 0, 0, 0); p1 = __builtin_amdgcn_mfma_f32_32x32x16_bf16(kf[2 * d0 + 1], qr[d0], p1, 0, 0, 0); }
            s16x4 vlo[8], vhi[8];
            { const LAS unsigned char* vq_ = lds + MB_VB + t * 8192 + vfo;
#pragma unroll
              for (int i = 0; i < 8; ++i) { vlo[i] = vtr(vq_ + (i & 1) * 4096 + (i >> 1) * 1024); vhi[i] = vtr(vq_ + (i & 1) * 4096 + (i >> 1) * 1024 + 512); } }
            __builtin_amdgcn_sched_barrier(0);
            { const LAS float* fb = fbl + 64 * t;
#pragma unroll
              for (int g = 0; g < 4; ++g) { const f32x4 fa = *(const LAS f32x4*)(fb + 8 * g + 4 * hi), fc = *(const LAS f32x4*)(fb + 32 + 8 * g + 4 * hi);
                  p0[4 * g + 0] += fa.x; p0[4 * g + 1] += fa.y; p0[4 * g + 2] += fa.z; p0[4 * g + 3] += fa.w; p1[4 * g + 0] += fc.x; p1[4 * g + 1] += fc.y; p1[4 * g + 2] += fc.z; p1[4 * g + 3] += fc.w; } }
            if (diag) { const int kbase = 64 * t + 4 * hi;
#pragma unroll
                for (int r = 0; r < 16; ++r) { const int kv = kbase + (r & 3) + 8 * (r >> 2); if (kv > qrel) p0[r] = -INFINITY; if (kv + 32 > qrel) p1[r] = -INFINITY; } }
            float rm = fmaxf(p0[0], p1[0]);
#pragma unroll
            for (int r = 1; r < 16; ++r) rm = fmaxf(rm, fmaxf(p0[r], p1[r]));
            rm = half_max(rm);
            if (__any(rm > mhat + AT_THR)) {
                const float mnew = fmaxf(mhat, rm), al = __builtin_amdgcn_exp2f(mhat - mnew); mhat = mnew; lsum *= al;
                if (hi == 0) wsf[r32] = al;
#pragma unroll
                for (int g = 0; g < 4; ++g) { const f32x4 a4 = *(const LAS f32x4*)(wsf + 8 * g + 4 * hi);
                    o0[4 * g + 0] *= a4.x; o0[4 * g + 1] *= a4.y; o0[4 * g + 2] *= a4.z; o0[4 * g + 3] *= a4.w; o1[4 * g + 0] *= a4.x; o1[4 * g + 1] *= a4.y; o1[4 * g + 2] *= a4.z; o1[4 * g + 3] *= a4.w; }
            }
            float ps = 0.f;
#pragma unroll
            for (int r = 0; r < 16; ++r) { p0[r] = __builtin_amdgcn_exp2f(p0[r] - mhat); p1[r] = __builtin_amdgcn_exp2f(p1[r] - mhat); ps += p0[r] + p1[r]; }
            lsum += ps;
            u32x4 pw0, pw1, pw2, pw3;
            pw0.x = cvt_pk_bf16(p0[0], p0[1]); pw0.y = cvt_pk_bf16(p0[2], p0[3]); pw0.z = cvt_pk_bf16(p0[4], p0[5]); pw0.w = cvt_pk_bf16(p0[6], p0[7]);
            pw1.x = cvt_pk_bf16(p0[8], p0[9]); pw1.y = cvt_pk_bf16(p0[10], p0[11]); pw1.z = cvt_pk_bf16(p0[12], p0[13]); pw1.w = cvt_pk_bf16(p0[14], p0[15]);
            pw2.x = cvt_pk_bf16(p1[0], p1[1]); pw2.y = cvt_pk_bf16(p1[2], p1[3]); pw2.z = cvt_pk_bf16(p1[4], p1[5]); pw2.w = cvt_pk_bf16(p1[6], p1[7]);
            pw3.x = cvt_pk_bf16(p1[8], p1[9]); pw3.y = cvt_pk_bf16(p1[10], p1[11]); pw3.z = cvt_pk_bf16(p1[12], p1[13]); pw3.w = cvt_pk_bf16(p1[14], p1[15]);
            __builtin_amdgcn_sched_barrier(0);
#define PV_STEP(OACC, I, PW) do { const bf16x8 vf_ = {vlo[I][0], vlo[I][1], vlo[I][2], vlo[I][3], vhi[I][0], vhi[I][1], vhi[I][2], vhi[I][3]}; \
                OACC = __builtin_amdgcn_mfma_f32_32x32x16_bf16(__builtin_bit_cast(bf16x8, PW), vf_, OACC, 0, 0, 0); } while (0)
            PV_STEP(o0, 0, pw0); PV_STEP(o1, 1, pw0); PV_STEP(o0, 2, pw1); PV_STEP(o1, 3, pw1);
            PV_STEP(o0, 4, pw2); PV_STEP(o1, 5, pw2); PV_STEP(o0, 6, pw3); PV_STEP(o1, 7, pw3);
#undef PV_STEP
        }
    }
    const float ltot = half_sum(lsum);
    if (hi == 0) wsf[r32] = 1.0f / ltot;
    bf16_t* Ow = Op + (rowbase + q0 + wid * 32) * opitch + h * 64 + r32;
#pragma unroll
    for (int g = 0; g < 4; ++g) { const f32x4 a4 = *(const LAS f32x4*)(wsf + 8 * g + 4 * hi);
#pragma unroll
        for (int j = 0; j < 4; ++j) { const int r = 4 * g + j; const float inv = (j == 0) ? a4.x : (j == 1) ? a4.y : (j == 2) ? a4.z : a4.w;
            bf16_t* orow = Ow + (size_t)crow(r, hi) * opitch;
            orow[0] = (bf16_t)(cvt_pk_bf16(o0[r] * inv, 0.f) & 0xffffu); orow[32] = (bf16_t)(cvt_pk_bf16(o1[r] * inv, 0.f) & 0xffffu); } }
    __syncthreads();
}

#ifndef E4F8_PAIR
#define E4F8_PAIR 1
#endif

struct Args { const float* in[19]; float* out; unsigned char* ws; };


typedef __attribute__((address_space(4))) const unsigned long long kq_t;
__device__ __forceinline__ kq_t* kargs() { kq_t* p = (kq_t*)__builtin_amdgcn_kernarg_segment_ptr(); asm volatile("" : "+s"(p)); return p; }
#define INP(k) ((const float*)(GAS const float*)kargs()[(k)])
#define OUTP ((float*)(GAS float*)kargs()[19])
#define WSP ((unsigned char*)(GAS unsigned char*)kargs()[20])
__device__ __forceinline__ void convert_even(int i, unsigned char* W, LAS unsigned char* lds, int vcu, int G) {
    const int tid = fresh_tid(), lane = tid & 63, wave = __builtin_amdgcn_readfirstlane(tid >> 6); LAS float* scr = (LAS float*)(lds + wave * 16384); const int gw = vcu * 8 + wave, NGW = G * 8;
    int base = 0;
    const float* w_in = INP(5) + (size_t)i * DM * EVEN_IN;
    conv_job(w_in, 0, DM, EVEN_IN, 0, 1536, (bf16_t*)(W + WE_IN), 0, 0, 0, nullptr, 0, 1, scr, gw, NGW, lane, base);
    conv_job(w_in, 0, DM, EVEN_IN, 1544, 512, (bf16_t*)(W + WE_IN), 0, 0, 1536, nullptr, 0, 1, scr, gw, NGW, lane, base);
    conv_job(INP(9) + (size_t)i * DM * DM, 0, DM, DM, 0, DM, (bf16_t*)(W + WE_OUT), 0, 0, 0, nullptr, 0, 1, scr, gw, NGW, lane, base);
    if (i == E4F8_PAIR) {
    conv_job8(INP(10) + (size_t)i * DM * FF, 0, DM, FF, FF, W + WE_GU, 0, 1, 0, S8_WGU, 1, (LAS unsigned char*)scr, gw, NGW, lane, base);
    conv_job8(INP(11) + (size_t)i * DM * FF, 0, DM, FF, FF, W + WE_GU, 0, 1, 128, S8_WGU, 1, (LAS unsigned char*)scr, gw, NGW, lane, base);
    } else {
    conv_job(INP(10) + (size_t)i * DM * FF, 0, DM, FF, 0, FF, (bf16_t*)(W + WE_GU), 0, 1, 0, nullptr, 0, 1, scr, gw, NGW, lane, base);
    conv_job(INP(11) + (size_t)i * DM * FF, 0, DM, FF, 0, FF, (bf16_t*)(W + WE_GU), 0, 1, 128, nullptr, 0, 1, scr, gw, NGW, lane, base);
    }
    conv_job8(INP(12) + (size_t)i * FF * DM, 0, FF, DM, DM, W + WE_DN, 0, 0, 0, S8_WDN, 1, (LAS unsigned char*)scr, gw, NGW, lane, base);
    conv_job(INP(7) + (size_t)i * 4 * 128 * 128, 128 * 128, 128, 128, 0, 128, (bf16_t*)(W + WE_POOL), 128 * 128, 0, 0, INP(8) + (size_t)i * 512, 128, 4, scr, gw, NGW, lane, base);
}
__device__ __forceinline__ void convert_odd(int i, unsigned char* W, LAS unsigned char* lds, int vcu, int G) {
    const int tid = fresh_tid(), lane = tid & 63, wave = __builtin_amdgcn_readfirstlane(tid >> 6); LAS float* scr = (LAS float*)(lds + wave * 16384); const int gw = vcu * 8 + wave, NGW = G * 8;
    int base = 0;
    conv_job8(INP(13) + (size_t)i * DM * 3 * DM, 0, DM, 3 * DM, 3 * DM, W + WO_IN, 0, 0, 0, S8_WGU, 1, (LAS unsigned char*)scr, gw, NGW, lane, base);
    conv_job(INP(14) + (size_t)i * DM * DM, 0, DM, DM, 0, DM, (bf16_t*)(W + WO_OUT), 0, 0, 0, nullptr, 0, 1, scr, gw, NGW, lane, base);
    conv_job8(INP(16) + (size_t)i * NEXP * DM * FF, (size_t)DM * FF, DM, FF, FF, W + WO_GU, (size_t)2 * FF * DM, 1, 0, S8_WGU, NEXP, (LAS unsigned char*)scr, gw, NGW, lane, base);
    conv_job8(INP(17) + (size_t)i * NEXP * DM * FF, (size_t)DM * FF, DM, FF, FF, W + WO_GU, (size_t)2 * FF * DM, 1, 128, S8_WGU, NEXP, (LAS unsigned char*)scr, gw, NGW, lane, base);
    conv_job8(INP(18) + (size_t)i * NEXP * FF * DM, (size_t)FF * DM, FF, DM, DM, W + WO_DN, (size_t)DM * FF, 0, 0, S8_WDN, NEXP, (LAS unsigned char*)scr, gw, NGW, lane, base);
}


#define NCV 384
#ifndef PMASK
#define PMASK 0xffffffffu
#endif
#define PH(k) if ((PMASK >> (k)) & 1u)
__global__ void __launch_bounds__(512, 2) trunk_fwd(Args a) {
    extern __shared__ __attribute__((aligned(16))) unsigned char lds_raw[];
    LAS unsigned char* lds = (LAS unsigned char*)lds_raw;
    volatile LAS unsigned* MISC = (volatile LAS unsigned*)(lds + MISC_OFF);
    const int tid = threadIdx.x;
    const int G0 = gridDim.x, bx0 = blockIdx.x;
    const int vcu0 = (bx0 % 8) * (G0 / 8) + bx0 / 8;
    for (int u = tid; u < (LDS_BYTES - MISC_OFF) / 4; u += 512) ((LAS unsigned*)(lds + MISC_OFF))[u] = 0u;
    __syncthreads();
    (void)xcd_barrier_post((unsigned*)(WSP + WS_CTL) + CW_BAR, MISC + 8);
#define GRID_BAR() do { XcdBarrier bar_; bar_.bar = (unsigned*)(WSP + WS_CTL) + CW_BAR; bar_.x = xb_xcc_id(); bar_.st = (volatile LAS unsigned*)(lds + MISC_OFF) + 8; xcd_barrier(bar_); } while (0)
#define G ls(G0)
#define bx ls(bx0)
#define vcu ls(vcu0)
#define XF OUTP
#define XB ((bf16_t*)(WSP + WS_XB))
#define WGT(off) ((const bf16_t*)(WSP + WS_W + (off)))
#define HC ((bf16_t*)(WSP + WS_BIG + BG_HC))
#define CAT ((bf16_t*)(WSP + WS_BIG + BG_CAT))
#define HID ((bf16_t*)(WSP + WS_BIG + BG_HID))
#define XS ((bf16_t*)(WSP + WS_XS))
#define XS8 (WSP + WS_BIG + BG_XS8)
#define YPRE ((bf16_t*)(WSP + WS_BIG + 256 * MiB))
#define HID8 (WSP + WS_BIG + BG_HID)
#define LOGF ((float*)(WSP + WS_LOGF))
#define FL ((float*)(WSP + WS_FL))
#define KMEAN ((float*)(WSP + WS_KMEAN))
#define RE ((unsigned*)(WSP + WS_RE))
#define RG ((f32x2*)(WSP + WS_RG))
#define RR ((unsigned*)(WSP + WS_RR))
#define POS ((i32x2*)(WSP + WS_POS))
#define CNT ((int*)(WSP + WS_CNT))
#define PB ((int*)(WSP + WS_PB))
#define QKV HC
#define OB CAT

    PH(0) convert_even(0, WSP + WS_W, lds, vcu, G);
    __syncthreads();
    PH(1) row_phase<RP_FORGET>(lds, vcu, INP(0), XF, XB, nullptr, nullptr, INP(5) + 1536, EVEN_IN, INP(6), LOGF, nullptr, nullptr, nullptr, nullptr, nullptr, nullptr, nullptr);
    GRID_BAR();

    for (int pair = 0; pair < 2; ++pair) {
        const int le = 2 * pair, lo = 2 * pair + 1;

        PH(2) if (vcu < 64) fox_scan(lds, vcu, LOGF, FL);
        PH(3) { pg8::Gemm g{XB, WGT(WE_IN), MTOK, 2048, DM}; pg8::StaticOrderT<8> S; S.init(MTOK, 2048, G, bx);
          pg8::EpiBf16 E{HC, 2048, 2, C2};
          pg8::gemm_phase<pg8::EpiBf16, pg8::StaticOrderT<8>, true, true>(lds, g, S, E); }
        GRID_BAR();


        PH(4) {
          gu32* qhead = (gu32*)(WSP + WS_CTL) + 64 + 64 * pair;
          volatile LAS unsigned* qslot = (volatile LAS unsigned*)(lds + MISC_OFF + 96);
#pragma unroll 1
          for (;;) {
              if (fresh_tid() == 0) qslot[0] = __hip_atomic_fetch_add(qhead, 1u, RLX_AGENT);
              __syncthreads();
              const int u = __builtin_amdgcn_readfirstlane((int)qslot[0]);
              __syncthreads();
              if (u >= 1024 + 512 + NCV) break;
              int v_;
              if (u < 4 * NCV) { if ((u & 3) == 3) { convert_odd(pair, WSP + WS_W, lds, u >> 2, NCV); continue; } v_ = u - (u >> 2); } else v_ = u - NCV;
              { const int u = v_;
              if (u < 1024) { const int h = 7 - (u >> 7), qb = 15 - ((u >> 3) & 15), b = u & 7;
                  fox_unit(lds, HC, HC + 512, HC + 1024, 2048, CAT, 1024, b, h, qb, FL + (size_t)(b * 8 + h) * SEQ); }
              else { const int v = u - 1024; pool_unit(lds, v >> 2, v & 3, HC, WGT(WE_POOL), CAT); } }
          } }
        GRID_BAR();


        PH(5) { pg8::Gemm g{CAT, WGT(WE_OUT), MTOK, DM, DM}; pg8::StaticOrderT<4> S; S.init(MTOK, DM, G, bx);
          pg8::EpiResid E{XB, YPRE, DM, ALPHA, 1.f};
          pg8::gemm_phase<pg8::EpiResid, pg8::StaticOrderT<4>, true, true>(lds, g, S, E); }
        GRID_BAR();
        PH(6) { if (pair == E4F8_PAIR) row_phase<RP_LN | RP_SRC_BF16 | RP_WRITE_X8>(lds, vcu, (const float*)YPRE, XF, XB, INP(1) + le * DM, INP(2) + le * DM, nullptr, 0, nullptr, nullptr, nullptr, nullptr, nullptr, nullptr, nullptr, nullptr, nullptr, XS8);
          else row_phase<RP_LN | RP_SRC_BF16>(lds, vcu, (const float*)YPRE, XF, XB, INP(1) + le * DM, INP(2) + le * DM, nullptr, 0, nullptr, nullptr, nullptr, nullptr, nullptr, nullptr, nullptr, nullptr, nullptr); }
        GRID_BAR();
        PH(7) { if (pair == E4F8_PAIR) { pg8::Gemm g{(const bf16_t*)XS8, WGT(WE_GU), MTOK, 2 * FF, DM / 2}; pg8::StaticOrderT<28> S; S.init(MTOK, 2 * FF, G, bx);
            pg8::EpiSwiGLU8 E{HID8, FF, 1.f / (S8_X * S8_WGU), S8_H};
            pg8::gemm_phase<pg8::EpiSwiGLU8, pg8::StaticOrderT<28>, true, true, true>(lds, g, S, E); }
          else { pg8::Gemm g{XB, WGT(WE_GU), MTOK, 2 * FF, DM}; pg8::StaticOrderT<28> S; S.init(MTOK, 2 * FF, G, bx);
            pg8::EpiSwiGLU8 E{HID8, FF, 1.f, S8_H};
            pg8::gemm_phase<pg8::EpiSwiGLU8, pg8::StaticOrderT<28>, true, true, false>(lds, g, S, E); } }
        GRID_BAR();
        PH(8) { pg8::Gemm g{(const bf16_t*)HID8, WGT(WE_DN), MTOK, DM, FF / 2}; pg8::StaticOrderT<4> S; S.init(MTOK, DM, G, bx);
          pg8::EpiResid E{XB, YPRE, DM, ALPHA, 1.f / (S8_H * S8_WDN)};
          pg8::gemm_phase<pg8::EpiResid, pg8::StaticOrderT<4>, true, true, true>(lds, g, S, E); }
        GRID_BAR();
        PH(9) row_phase<RP_LN | RP_SRC_BF16 | RP_WRITE_X8>(lds, vcu, (const float*)YPRE, XF, XB, INP(3) + le * DM, INP(4) + le * DM, nullptr, 0, nullptr, nullptr, nullptr, nullptr, nullptr, nullptr, nullptr, nullptr, nullptr, XS8);
        GRID_BAR();

        PH(11) { pg8::Gemm g{(const bf16_t*)XS8, WGT(WO_IN), MTOK, 3 * DM, DM / 2}; pg8::StaticOrderT<12> S; S.init(MTOK, 3 * DM, G, bx);
          pg8::EpiBf16 E{QKV, 3 * DM, 4, C2 / (S8_X * S8_WGU), 1.f / (S8_X * S8_WGU)};
          pg8::gemm_phase<pg8::EpiBf16, pg8::StaticOrderT<12>, true, true, true>(lds, g, S, E); }
        GRID_BAR();
        PH(12) kmean_unit(lds, vcu, QKV + DM, KMEAN);
        GRID_BAR();
        PH(13) moba_part(lds, vcu, QKV, QKV + DM, QKV + 2 * DM, 3 * DM, OB, DM, KMEAN, (bf16_t*)(WSP + WS_BIG + 256 * MiB), (f32x2*)(WSP + WS_XS));
        GRID_BAR();
        PH(14) { pg8::Gemm g{OB, WGT(WO_OUT), MTOK, DM, DM}; pg8::StaticOrderT<4> S; S.init(MTOK, DM, G, bx);
          pg8::EpiResid E{XB, YPRE, DM, ALPHA, 1.f};
          pg8::gemm_phase<pg8::EpiResid, pg8::StaticOrderT<4>, true, true>(lds, g, S, E); }
        GRID_BAR();
        PH(15) row_phase<RP_LN | RP_ROUTER | RP_SRC_BF16>(lds, vcu, (const float*)YPRE, XF, XB, INP(1) + lo * DM, INP(2) + lo * DM, INP(15) + (size_t)pair * DM * NEXP, NEXP, nullptr, nullptr, nullptr, nullptr, nullptr, RE, RG, RR, CNT);
        GRID_BAR();
        PH(16) moe_sort(lds, vcu, CNT, RE, RR, XB, XS8, POS, PB);
        GRID_BAR();
        { const int np = __builtin_amdgcn_readfirstlane(PB[8]);
          { LAS int* pl = (LAS int*)(lds + MISC_OFF + 2048); for (int i = fresh_tid(); i < np; i += 512) pl[i] = PB[16 + i]; __syncthreads(); }
          PH(17) { pg8::Gemm g{(const bf16_t*)XS8, WGT(WO_GU), np * 256, 2 * FF, DM / 2}; pg8::MoeOrderT<28> S; S.init(np, 2 * FF, G, bx, (LAS int*)(lds + MISC_OFF + 2048));
            pg8::EpiSwiGLU8 E{HID8, FF, 1.f / (S8_X * S8_WGU), S8_H};
            pg8::gemm_phase<pg8::EpiSwiGLU8, pg8::MoeOrderT<28>, true, true, true>(lds, g, S, E); }
          GRID_BAR();
          PH(18) { pg8::Gemm g{(const bf16_t*)HID8, WGT(WO_DN), np * 256, DM, FF / 2}; pg8::MoeOrderT<4> S; S.init(np, DM, G, bx, (LAS int*)(lds + MISC_OFF + 2048));
            pg8::EpiBf16 E{XS, DM, 1 << 30, 1.f / (S8_H * S8_WDN)};
            pg8::gemm_phase<pg8::EpiBf16, pg8::MoeOrderT<4>, true, true, true>(lds, g, S, E); }
          GRID_BAR(); }
        if (pair == 0) {
            PH(19) row_phase<RP_LN | RP_COMBINE | RP_FORGET | RP_SRC_BF16>(lds, vcu, (const float*)XB, XF, XB, INP(3) + lo * DM, INP(4) + lo * DM,
                INP(5) + (size_t)(pair + 1) * DM * EVEN_IN + 1536, EVEN_IN, INP(6) + (pair + 1) * 8, LOGF, XS, RG, POS, nullptr, nullptr, nullptr, nullptr);
            PH(20) convert_even(pair + 1, WSP + WS_W, lds, vcu, G);
            GRID_BAR();
        } else {
            PH(21) row_phase<RP_LN | RP_WRITE_XF | RP_COMBINE | RP_SRC_BF16>(lds, vcu, (const float*)XB, XF, XB, INP(3) + lo * DM, INP(4) + lo * DM,
                nullptr, 0, nullptr, nullptr, XS, RG, POS, nullptr, nullptr, nullptr, nullptr);
        }
    }
}

#undef G
#undef bx
#undef vcu
#undef XF
#undef XB
#undef HC
#undef CAT
#undef HID
#undef XS
#undef XS8
#undef YPRE
#undef HID8
#undef LOGF
#undef FL
#undef KMEAN
#undef RE
#undef RG
#undef RR
#undef POS
#undef CNT
#undef PB
#undef QKV
#undef OB
extern "C" void kernel_launch(void* const* d_in, const int* in_sizes, int n_in, void* d_out, int out_size, void* d_ws, size_t ws_size, hipStream_t stream) {
    static int grid = 0;
    if (grid == 0) {
        if (n_in != 19 || in_sizes[0] != MTOK * DM || out_size != MTOK * DM || ws_size < WS_END) { fprintf(stderr, "kernel_launch: unexpected shapes (n_in %d, out %d, ws %zu); nothing launched\n", n_in, out_size, ws_size); grid = -1; return; }
        int dev = 0, cus = 0, per_cu = 0;
        if (hipGetDevice(&dev) != hipSuccess || hipDeviceGetAttribute(&cus, hipDeviceAttributeMultiprocessorCount, dev) != hipSuccess) { grid = -1; return; }
        if (hipFuncSetAttribute((const void*)trunk_fwd, hipFuncAttributeMaxDynamicSharedMemorySize, LDS_BYTES) != hipSuccess) { fprintf(stderr, "kernel_launch: hipFuncSetAttribute failed\n"); grid = -1; return; }
        if (hipOccupancyMaxActiveBlocksPerMultiprocessor(&per_cu, (const void*)trunk_fwd, 512, LDS_BYTES) != hipSuccess || per_cu < 1) fprintf(stderr, "kernel_launch: occupancy query reports %d\n", per_cu);
        (void)hipGetLastError();
        grid = cus;
        if (grid != 256) { fprintf(stderr, "kernel_launch: built for 256 CUs, found %d; nothing launched\n", cus); grid = -1; return; }
    }
    if (grid < 0) return;
    if (hipMemsetAsync((char*)d_ws + WS_CTL, 0, CTL_ZERO_BYTES, stream) != hipSuccess) return;
    Args a{};
    for (int i = 0; i < 19; ++i) a.in[i] = (const float*)d_in[i];
    a.out = (float*)d_out; a.ws = (unsigned char*)d_ws;
    hipLaunchKernelGGL(trunk_fwd, dim3(grid), dim3(512), LDS_BYTES, stream, a);
}
```

```cpp
#include <hip/hip_runtime.h>
#include <cstdio>
#include <cstdint>

#define LAS __attribute__((address_space(3)))
#define GAS __attribute__((address_space(1)))
typedef unsigned short bf16_t;
typedef short bf16x8 __attribute__((ext_vector_type(8)));
typedef short s16x4 __attribute__((ext_vector_type(4)));
typedef float f32x4 __attribute__((ext_vector_type(4)));
typedef float f32x2 __attribute__((ext_vector_type(2)));
typedef float f32x16 __attribute__((ext_vector_type(16)));
typedef unsigned u32x4 __attribute__((ext_vector_type(4)));
typedef unsigned u32x2 __attribute__((ext_vector_type(2)));
typedef int i32x2 __attribute__((ext_vector_type(2)));

constexpr int NB = 8, SEQ = 4096, DM = 1024, MTOK = NB * SEQ, FF = 3584, NEXP = 8;
constexpr int FOXH = 8, MOBAH = 16, EVEN_IN = 2056;
constexpr float ALPHA = 1.6817928305074290f;
constexpr float LN_EPS = 1e-5f;
constexpr float LOG2E = 1.4426950408889634f;
constexpr float C2 = 0.125f * 1.4426950408889634f;
constexpr int MAXROWS = 2 * MTOK + NEXP * 256;

typedef __bf16 bf16x2_t __attribute__((ext_vector_type(2)));
__device__ __forceinline__ unsigned cvt_pk_bf16(float lo, float hi) { const f32x2 v = {lo, hi}; const bf16x2_t b = __builtin_convertvector(v, bf16x2_t); return __builtin_bit_cast(unsigned, b); }
__device__ __forceinline__ float bf_lo(unsigned u) { return __uint_as_float(u << 16); }
__device__ __forceinline__ float bf_hi(unsigned u) { return __uint_as_float(u & 0xffff0000u); }

__device__ __forceinline__ int ls(int x) { asm volatile("" : "+s"(x)); return x; }
__device__ __forceinline__ float lane_xor(float v, int lane, int o) { return __int_as_float(__builtin_amdgcn_ds_bpermute((lane ^ o) << 2, __float_as_int(v))); }
__device__ __forceinline__ int fresh_tid() { int t = threadIdx.x; asm volatile("" : "+v"(t)); return t; }

namespace pg8 {
#define PG8_LAS __attribute__((address_space(3)))
constexpr int BM = 256, BK = 64, HALF = 128, HTB = HALF * BK * 2, STAGE_BYTES = 8 * HTB, NXCD = 8, WGM = 8;
__host__ __device__ __forceinline__ int lds_byte(int r, int c) { const int st = (r >> 4) * 2 + (c >> 5), rr = r & 15, cc = c & 31, ob = rr * 64 + cc * 2; return st * 1024 + (ob ^ (((ob >> 9) & 1) << 5)); }
__host__ __device__ __forceinline__ void stage_rc(int b, int& R, int& C) { const int st = b / 1024, sb = b % 1024, swz = sb ^ (((sb >> 9) & 1) << 5); R = (st >> 1) * 16 + swz / 64; C = (st & 1) * 32 + (swz % 64) / 2; }
__host__ __device__ __forceinline__ int perm32(int rho) { const int n = rho >> 4, i = rho & 15; return 8 * (i >> 2) + 4 * n + (i & 3); }

struct Unit { int pm, pn, pb; };
struct Gemm { const bf16_t* A; const bf16_t* Bt; int M, N, K; };

template <int NN> struct StaticOrderT {
    int nM, nwg, G, c;
    __device__ void init(int M, int  , int G_, int c_) { nM = M / BM; nwg = nM * NN; G = G_; c = c_; }
    __device__ bool next(int i, Unit& u) const {
        const int L = i * G + c; if (L >= nwg) return false;
        int wgid = L; { const int q = nwg / NXCD, r = nwg % NXCD, xcd = wgid % NXCD, off = wgid / NXCD; wgid = (xcd < r ? xcd * (q + 1) : r * (q + 1) + (xcd - r) * q) + off; }
        constexpr int nig = WGM * NN; const int gid = wgid / nig, fm = gid * WGM, rem = wgid % nig, left = nM - fm;
        if (left >= WGM) { u.pm = fm + rem % WGM; u.pn = rem / WGM; } else { u.pm = fm + rem % left; u.pn = rem / left; }
        u.pb = u.pn; return true;
    }
    __device__ __forceinline__ void a_ready(const Unit&) const {}
    __device__ __forceinline__ void done(const Unit&) const {}
};
template <int NN> struct MoeOrderT {
    int nM, nwg, G, c; const PG8_LAS int* pe;
    __device__ __forceinline__ void init(int nPanels, int  , int G_, int c_, PG8_LAS int* pl) { nM = nPanels; nwg = nM * NN; G = G_; c = c_; pe = pl; }
    __device__ bool next(int i, Unit& u) const {
        const int L = i * G + c; if (L >= nwg) return false;
        int wgid = L; { const int q = nwg / NXCD, r = nwg % NXCD, xcd = wgid % NXCD, off = wgid / NXCD; wgid = (xcd < r ? xcd * (q + 1) : r * (q + 1) + (xcd - r) * q) + off; }
        constexpr int nig = WGM * NN; const int gid = wgid / nig, fm = gid * WGM, rem = wgid % nig, left = nM - fm;
        if (left >= WGM) { u.pm = fm + rem % WGM; u.pn = rem / WGM; } else { u.pm = fm + rem % left; u.pn = rem / left; }
        u.pb = __builtin_amdgcn_readfirstlane(pe[u.pm]) * NN + u.pn; return true;
    }
    __device__ __forceinline__ void a_ready(const Unit&) const {}
    __device__ __forceinline__ void done(const Unit&) const {}
};

typedef int i32x4v __attribute__((ext_vector_type(4)));
typedef int i32x8v __attribute__((ext_vector_type(8)));
__device__ __forceinline__ i32x8v cat8(const bf16x8& lo, const bf16x8& hi) { const i32x4v a = __builtin_bit_cast(i32x4v, lo), b = __builtin_bit_cast(i32x4v, hi); return __builtin_shufflevector(a, b, 0, 1, 2, 3, 4, 5, 6, 7); }
template <bool F8> __device__ __forceinline__ void mma_block(f32x4 (&acc)[4][2], const bf16x8 (&At)[4][2], const bf16x8 (&Bt)[2][2], const i32x8v (&At8)[4], const i32x8v (&Bt8)[2]) {
    if constexpr (!F8) {
#pragma unroll
        for (int m = 0; m < 4; ++m)
#pragma unroll
            for (int n = 0; n < 2; ++n)
#pragma unroll
                for (int k = 0; k < 2; ++k) acc[m][n] = __builtin_amdgcn_mfma_f32_16x16x32_bf16(Bt[n][k], At[m][k], acc[m][n], 0, 0, 0);
    } else {
#pragma unroll
        for (int m = 0; m < 4; ++m)
#pragma unroll
            for (int n = 0; n < 2; ++n) asm volatile("v_mfma_scale_f32_16x16x128_f8f6f4 %0, %1, %2, %0, %3, %3 op_sel_hi:[0,0,0]" : "+v"(acc[m][n]) : "v"(Bt8[n]), "v"(At8[m]), "v"(0x7f7f7f7f));
    }
}

struct EpiBf16 {
    static constexpr int NVM = 16;     static constexpr bool PERM = true, AFTER_DRAIN = false;
    bf16_t* O; int ldc; int nscale; float scale0; float scale1 = 1.f;
    __device__ __forceinline__ void operator()(const f32x4 (&acc)[2][2][4][2], const Unit& u, int wr, int wc, int fr, int fq) const {
        asm volatile("" : "+v"(fr), "+v"(fq));
        const int row0 = u.pm * BM + wr * 64 + fr; const int col0 = u.pn * BM + wc * 32 + 8 * fq;
        const float sc = (u.pn < nscale) ? scale0 : scale1;
#pragma unroll
        for (int ai = 0; ai < 2; ++ai)
#pragma unroll
            for (int m = 0; m < 4; ++m) { bf16_t* rowp = O + (size_t)(row0 + ai * HALF + m * 16) * ldc + col0;
#pragma unroll
                for (int bj = 0; bj < 2; ++bj) { const f32x4 v0 = acc[ai][bj][m][0] * sc, v1 = acc[ai][bj][m][1] * sc;
                    u32x4 w; w.x = cvt_pk_bf16(v0[0], v0[1]); w.y = cvt_pk_bf16(v0[2], v0[3]); w.z = cvt_pk_bf16(v1[0], v1[1]); w.w = cvt_pk_bf16(v1[2], v1[3]);
                    *(u32x4*)(rowp + bj * HALF) = w; } }
    }
};
__device__ __forceinline__ float silu_mul(float g, float u) { const float e = __builtin_amdgcn_exp2f(-g * LOG2E); return g * __builtin_amdgcn_rcpf(1.0f + e) * u; }
struct EpiSwiGLU {
    static constexpr int NVM = 8;     static constexpr bool PERM = true, AFTER_DRAIN = false;
    bf16_t* O; int ldc;
    __device__ __forceinline__ void operator()(const f32x4 (&acc)[2][2][4][2], const Unit& u, int wr, int wc, int fr, int fq) const {
        asm volatile("" : "+v"(fr), "+v"(fq));
        const int row0 = u.pm * BM + wr * 64 + fr; const int col0 = u.pn * HALF + wc * 32 + 8 * fq;
#pragma unroll
        for (int ai = 0; ai < 2; ++ai)
#pragma unroll
            for (int m = 0; m < 4; ++m) { bf16_t* rowp = O + (size_t)(row0 + ai * HALF + m * 16) * ldc + col0;
                const f32x4 g0 = acc[ai][0][m][0], g1 = acc[ai][0][m][1], u0 = acc[ai][1][m][0], u1 = acc[ai][1][m][1];
                u32x4 w; w.x = cvt_pk_bf16(silu_mul(g0[0], u0[0]), silu_mul(g0[1], u0[1])); w.y = cvt_pk_bf16(silu_mul(g0[2], u0[2]), silu_mul(g0[3], u0[3]));
                w.z = cvt_pk_bf16(silu_mul(g1[0], u1[0]), silu_mul(g1[1], u1[1])); w.w = cvt_pk_bf16(silu_mul(g1[2], u1[2]), silu_mul(g1[3], u1[3]));
                *(u32x4*)rowp = w; }
    }
};
__device__ __forceinline__ float clamp448(float x) { return fminf(fmaxf(x, -448.f), 448.f); }
__device__ __forceinline__ unsigned pack4_fp8(float a, float b, float c, float d) { int w = 0; w = __builtin_amdgcn_cvt_pk_fp8_f32(clamp448(a), clamp448(b), w, false); w = __builtin_amdgcn_cvt_pk_fp8_f32(clamp448(c), clamp448(d), w, true); return (unsigned)w; }
struct EpiSwiGLU8 {
    static constexpr int NVM = 8;     static constexpr bool PERM = true, AFTER_DRAIN = false;
    unsigned char* O; int ldc; float inscale, outscale;
    static __device__ __forceinline__ unsigned h4(const f32x4 g, const f32x4 u, const f32x2 kn, const f32x2 ko) {
        const f32x2 ga = {g[0], g[1]}, gb = {g[2], g[3]}, ua = {u[0], u[1]}, ub = {u[2], u[3]};
        const f32x2 ta = ga * kn, tb = gb * kn;
        const f32x2 one = {1.0f, 1.0f};
        const f32x2 da = (f32x2){__builtin_amdgcn_exp2f(ta.x), __builtin_amdgcn_exp2f(ta.y)} + one, db = (f32x2){__builtin_amdgcn_exp2f(tb.x), __builtin_amdgcn_exp2f(tb.y)} + one;
        const f32x2 ra = {__builtin_amdgcn_rcpf(da.x), __builtin_amdgcn_rcpf(da.y)}, rb = {__builtin_amdgcn_rcpf(db.x), __builtin_amdgcn_rcpf(db.y)};
        const f32x2 pa = ((ga * ua) * ra) * ko, pb = ((gb * ub) * rb) * ko;
        return pack4_fp8(pa.x, pa.y, pb.x, pb.y);
    }
    __device__ __forceinline__ void operator()(const f32x4 (&acc)[2][2][4][2], const Unit& u, int wr, int wc, int fr, int fq) const {
        asm volatile("" : "+v"(fr), "+v"(fq));
        const int row0 = u.pm * BM + wr * 64 + fr; const int col0 = u.pn * HALF + wc * 32 + 8 * fq;
        const float kn_ = -inscale * LOG2E, ko_ = inscale * inscale * outscale;
        const f32x2 kn = {kn_, kn_}, ko = {ko_, ko_};
#pragma unroll
        for (int ai = 0; ai < 2; ++ai)
#pragma unroll
            for (int m = 0; m < 4; ++m) { unsigned char* rowp = O + (size_t)(row0 + ai * HALF + m * 16) * ldc + col0;
                u32x2 w; w.x = h4(acc[ai][0][m][0], acc[ai][1][m][0], kn, ko); w.y = h4(acc[ai][0][m][1], acc[ai][1][m][1], kn, ko);
                *(u32x2*)rowp = w; }
    }
};
struct EpiResid {
    static constexpr int NVM = 32;     static constexpr bool PERM = true, AFTER_DRAIN = false;
    const bf16_t* base; bf16_t* out; int ldc; float alpha, accscale;
    __device__ __forceinline__ void operator()(const f32x4 (&acc)[2][2][4][2], const Unit& u, int wr, int wc, int fr, int fq) const {
        asm volatile("" : "+v"(fr), "+v"(fq));
        const int row0 = u.pm * BM + wr * 64 + fr; const int col0 = u.pn * BM + wc * 32 + 8 * fq;
#pragma unroll
        for (int ai = 0; ai < 2; ++ai)
#pragma unroll
            for (int m = 0; m < 4; ++m) { const size_t off = (size_t)(row0 + ai * HALF + m * 16) * ldc + col0;
                u32x4 bs[2];
#pragma unroll
                for (int bj = 0; bj < 2; ++bj) bs[bj] = *(const u32x4*)(base + off + bj * HALF);
#pragma unroll
                for (int bj = 0; bj < 2; ++bj) { const f32x4 v0 = acc[ai][bj][m][0] * accscale, v1 = acc[ai][bj][m][1] * accscale; const u32x4 b = bs[bj];
                    u32x4 w; w.x = cvt_pk_bf16(bf_lo(b.x) * alpha + v0[0], bf_hi(b.x) * alpha + v0[1]); w.y = cvt_pk_bf16(bf_lo(b.y) * alpha + v0[2], bf_hi(b.y) * alpha + v0[3]);
                    w.z = cvt_pk_bf16(bf_lo(b.z) * alpha + v1[0], bf_hi(b.z) * alpha + v1[1]); w.w = cvt_pk_bf16(bf_lo(b.w) * alpha + v1[2], bf_hi(b.w) * alpha + v1[3]);
                    *(u32x4*)(out + off + bj * HALF) = w; }
                asm volatile("" ::: "memory"); }
    }
};
template <class Epi, class Sched, bool ALIGN_EPI = false, bool SP2 = false, bool F8 = false>
__device__ __forceinline__ void gemm_phase(PG8_LAS unsigned char* lds, const Gemm g, const Sched& S, const Epi& E) {
    const int tid = fresh_tid(), wid = __builtin_amdgcn_readfirstlane(tid >> 6), lane = tid & 63, wr = wid >> 2, wc = wid & 3, fr = lane & 15, fq = lane >> 4;
    const int K = g.K, nt = K / BK;
    unsigned voffA[2], voffB[2];
#pragma unroll
    for (int i = 0; i < 2; ++i) { int R, C; stage_rc(tid * 16 + i * 8192, R, C); const int Rb = Epi::PERM ? ((R & ~31) + perm32(R & 31)) : R;
        voffA[i] = (unsigned)(R * K + C) * 2u; voffB[i] = (unsigned)(Rb * K + C) * 2u; }
    const size_t kstep = (size_t)(BK * 2);
    const size_t hstep = (size_t)HALF * K * 2;
    const size_t tstep = 2 * hstep;
    const unsigned ldsw = (unsigned)wid * 1024u;
    const int aoff = lds_byte(wr * 64 + fr, fq * 8), boff = lds_byte(wc * 32 + fr, fq * 8);
#define PG8_SA(b, h) (((b) * 2 + (h)) * HTB)
#define PG8_SB(b, h) ((4 + (b) * 2 + (h)) * HTB)
#define PG8_STAGE(bufoff, gbase, voff) do { _Pragma("unroll") for (int _i = 0; _i < 2; ++_i) \
        __builtin_amdgcn_global_load_lds((const unsigned*)((const char*)(gbase) + (voff)[_i]), (PG8_LAS unsigned*)(lds + (bufoff) + ldsw + _i * 8192), 16, 0, 0); } while (0)
#define PG8_LDA(dst, b, h) do { if constexpr (!F8) { _Pragma("unroll") for (int m = 0; m < 4; ++m) _Pragma("unroll") for (int k = 0; k < 2; ++k) dst[m][k] = *(const PG8_LAS bf16x8*)(lds + PG8_SA(b, h) + aoff + m * 2048 + k * 1024); } \
        else { _Pragma("unroll") for (int m = 0; m < 4; ++m) { const i32x4v lo_ = *(const PG8_LAS i32x4v*)(lds + PG8_SA(b, h) + aoff + m * 2048), hi_ = *(const PG8_LAS i32x4v*)(lds + PG8_SA(b, h) + aoff + m * 2048 + 1024); dst##8[m] = __builtin_shufflevector(lo_, hi_, 0, 1, 2, 3, 4, 5, 6, 7); } } } while (0)
#define PG8_LDB(dst, b, h) do { if constexpr (!F8) { _Pragma("unroll") for (int n = 0; n < 2; ++n) _Pragma("unroll") for (int k = 0; k < 2; ++k) dst[n][k] = *(const PG8_LAS bf16x8*)(lds + PG8_SB(b, h) + boff + n * 2048 + k * 1024); } \
        else { _Pragma("unroll") for (int n = 0; n < 2; ++n) { const i32x4v lo_ = *(const PG8_LAS i32x4v*)(lds + PG8_SB(b, h) + boff + n * 2048), hi_ = *(const PG8_LAS i32x4v*)(lds + PG8_SB(b, h) + boff + n * 2048 + 1024); dst##8[n] = __builtin_shufflevector(lo_, hi_, 0, 1, 2, 3, 4, 5, 6, 7); } } } while (0)
#define PG8_MMA(ai, bj, At, Bt) do { __builtin_amdgcn_s_setprio(1); mma_block<F8>(acc[ai][bj], At, Bt, At##8, Bt##8); __builtin_amdgcn_s_setprio(0); } while (0)
#define PG8_WAIT_V(n) asm volatile("s_waitcnt vmcnt(" #n ")" ::: "memory")
#define PG8_WAIT_VN(n) asm volatile("s_waitcnt vmcnt(%0)" :: "n"(n) : "memory")
#define PG8_WAIT_L(n) asm volatile("s_waitcnt lgkmcnt(" #n ")" ::: "memory")
#define PG8_BAR __builtin_amdgcn_s_barrier()
#define PG8_SCHED __builtin_amdgcn_sched_barrier(0)
    Unit cur, nxt; int ui = 0;
    if (!S.next(0, cur)) return;
    f32x4 acc[2][2][4][2];
#pragma unroll
    for (int a = 0; a < 2; ++a)
#pragma unroll
        for (int b = 0; b < 2; ++b)
#pragma unroll
            for (int m = 0; m < 4; ++m)
#pragma unroll
                for (int n = 0; n < 2; ++n) acc[a][b][m][n] = (f32x4){0.f, 0.f, 0.f, 0.f};
    bf16x8 At[4][2], B0[2][2], B1[2][2];
    i32x8v At8[4], B08[2], B18[2];
    const char* cA = (const char*)g.A + (size_t)cur.pm * tstep; const char* cB = (const char*)g.Bt + (size_t)cur.pb * tstep;
    S.a_ready(cur);
    if constexpr (SP2) {
        PG8_STAGE(PG8_SB(0, 0), cB, voffB); PG8_STAGE(PG8_SB(0, 1), cB + hstep, voffB); PG8_STAGE(PG8_SA(0, 0), cA, voffA); PG8_STAGE(PG8_SA(0, 1), cA + hstep, voffA);
        PG8_STAGE(PG8_SB(1, 0), cB + kstep, voffB); PG8_STAGE(PG8_SA(1, 0), cA + kstep, voffA); PG8_STAGE(PG8_SB(1, 1), cB + hstep + kstep, voffB); PG8_STAGE(PG8_SA(1, 1), cA + hstep + kstep, voffA);
        if (wr == 1) PG8_BAR;
        PG8_WAIT_V(0); PG8_BAR;
        PG8_BAR;
    } else {
        PG8_STAGE(PG8_SB(0, 0), cB, voffB); PG8_STAGE(PG8_SA(0, 0), cA, voffA); PG8_STAGE(PG8_SB(0, 1), cB + hstep, voffB); PG8_STAGE(PG8_SA(0, 1), cA + hstep, voffA);
        if (wr == 1) PG8_BAR;
        PG8_WAIT_V(4); PG8_BAR;
        PG8_STAGE(PG8_SB(1, 0), cB + kstep, voffB); PG8_STAGE(PG8_SA(1, 0), cA + kstep, voffA); PG8_STAGE(PG8_SB(1, 1), cB + hstep + kstep, voffB);
        PG8_WAIT_V(6); PG8_BAR;
    }
    for (;;) {
        const bool has_next = S.next(ui + 1, nxt);
        const char* nA = has_next ? (const char*)g.A + (size_t)nxt.pm * tstep : cA; const char* nB = has_next ? (const char*)g.Bt + (size_t)nxt.pb * tstep : cB;
        if constexpr (SP2) {
#define PG8_WAIT_V8X() do { if (t == 0) PG8_WAIT_VN(8 + Epi::NVM); else PG8_WAIT_V(8); } while (0)
#pragma unroll 1
        for (int t = 0; t < nt; t += 2) {
            const bool last = (t == nt - 2);
            const char* a1 = cA + (size_t)(t + 1) * kstep;
            const char* a2 = last ? nA : cA + (size_t)(t + 2) * kstep; const char* b2 = last ? nB : cB + (size_t)(t + 2) * kstep;
            const char* a3 = a2 + kstep; const char* b3 = b2 + kstep;
            if (last && has_next) S.a_ready(nxt);
            PG8_LDB(B0, 0, 0); PG8_LDB(B1, 0, 1); PG8_SCHED; PG8_LDA(At, 0, 0); if (t != 0) PG8_STAGE(PG8_SA(1, 1), a1 + hstep, voffA);
            PG8_WAIT_V8X(); PG8_WAIT_L(0); PG8_BAR; PG8_MMA(0, 0, At, B0); PG8_MMA(0, 1, At, B1); PG8_BAR; PG8_SCHED;
            PG8_LDA(At, 0, 1); PG8_STAGE(PG8_SB(0, 0), b2, voffB); PG8_STAGE(PG8_SB(0, 1), b2 + hstep, voffB); PG8_STAGE(PG8_SA(0, 0), a2, voffA);
            PG8_WAIT_V8X(); PG8_WAIT_L(0); PG8_BAR; PG8_MMA(1, 0, At, B0); PG8_MMA(1, 1, At, B1); PG8_BAR; PG8_SCHED;
            PG8_LDB(B0, 1, 0); PG8_LDB(B1, 1, 1); PG8_SCHED; PG8_LDA(At, 1, 0); PG8_STAGE(PG8_SA(0, 1), a2 + hstep, voffA);
            PG8_WAIT_V8X(); PG8_WAIT_L(0); PG8_BAR; PG8_MMA(0, 0, At, B0); PG8_MMA(0, 1, At, B1); PG8_BAR; PG8_SCHED;
            PG8_LDA(At, 1, 1); PG8_STAGE(PG8_SB(1, 0), b3, voffB); PG8_STAGE(PG8_SB(1, 1), b3 + hstep, voffB); PG8_STAGE(PG8_SA(1, 0), a3, voffA);
            PG8_WAIT_V(8); PG8_WAIT_L(0); PG8_BAR; PG8_MMA(1, 0, At, B0); PG8_MMA(1, 1, At, B1); PG8_BAR; PG8_SCHED;
        }
#undef PG8_WAIT_V8X
        } else {
        for (int t = 0; t < nt; t += 2) {
            const bool last = (t == nt - 2);
            const char* a1 = cA + (size_t)(t + 1) * kstep;
            const char* a2 = last ? nA : cA + (size_t)(t + 2) * kstep; const char* b2 = last ? nB : cB + (size_t)(t + 2) * kstep;
            const char* a3 = a2 + kstep; const char* b3 = b2 + kstep;
            if (last && has_next) S.a_ready(nxt);
            PG8_LDB(B0, 0, 0); PG8_SCHED; PG8_LDA(At, 0, 0); PG8_STAGE(PG8_SA(1, 1), a1 + hstep, voffA);
            PG8_WAIT_L(8); PG8_BAR; PG8_WAIT_L(0); PG8_MMA(0, 0, At, B0); PG8_BAR; PG8_SCHED;
            PG8_LDB(B1, 0, 1); PG8_STAGE(PG8_SB(0, 0), b2, voffB);
            PG8_BAR; PG8_WAIT_L(0); PG8_MMA(0, 1, At, B1); PG8_BAR;
            PG8_LDA(At, 0, 1); PG8_STAGE(PG8_SA(0, 0), a2, voffA);
            PG8_BAR; PG8_WAIT_L(0); PG8_MMA(1, 0, At, B0); PG8_BAR; PG8_SCHED;
            PG8_STAGE(PG8_SB(0, 1), b2 + hstep, voffB);
            PG8_WAIT_V(6); PG8_BAR; PG8_MMA(1, 1, At, B1); PG8_BAR;
            PG8_LDB(B0, 1, 0); PG8_SCHED; PG8_LDA(At, 1, 0); PG8_STAGE(PG8_SA(0, 1), a2 + hstep, voffA);
            PG8_WAIT_L(8); PG8_BAR; PG8_WAIT_L(0); PG8_MMA(0, 0, At, B0); PG8_BAR; PG8_SCHED;
            PG8_LDB(B1, 1, 1); PG8_STAGE(PG8_SB(1, 0), b3, voffB);
            PG8_BAR; PG8_WAIT_L(0); PG8_MMA(0, 1, At, B1); PG8_BAR;
            PG8_LDA(At, 1, 1); PG8_STAGE(PG8_SA(1, 0), a3, voffA);
            PG8_BAR; PG8_WAIT_L(0); PG8_MMA(1, 0, At, B0); PG8_BAR; PG8_SCHED;
            PG8_STAGE(PG8_SB(1, 1), b3 + hstep, voffB);
            PG8_WAIT_V(6); PG8_BAR; PG8_MMA(1, 1, At, B1); PG8_BAR;
        }
        }
        if constexpr (SP2) PG8_STAGE(PG8_SA(1, 1), nA + kstep + hstep, voffA);
        if constexpr (F8) asm volatile("s_nop 15\n\ts_nop 15" ::: "memory");
        if constexpr (ALIGN_EPI) { if (wr == 0) PG8_BAR; }
        if constexpr (!Epi::AFTER_DRAIN) { E(acc, cur, wr, wc, fr, fq); S.done(cur); }
        if (!has_next) break;
#pragma unroll
        for (int a = 0; a < 2; ++a)
#pragma unroll
            for (int b = 0; b < 2; ++b)
#pragma unroll
                for (int m = 0; m < 4; ++m)
#pragma unroll
                    for (int n = 0; n < 2; ++n) acc[a][b][m][n] = (f32x4){0.f, 0.f, 0.f, 0.f};
        cur = nxt; cA = nA; cB = nB; ++ui;
        if constexpr (ALIGN_EPI) { if (wr == 1) PG8_BAR; }
    }
    PG8_WAIT_V(0);
    if constexpr (!ALIGN_EPI) { if (wr == 0) PG8_BAR; }
    PG8_BAR;
    if constexpr (Epi::AFTER_DRAIN) { E.fused(acc, cur, wr, wc, fr, fq, lds, wid, lane); S.done(cur); }
#undef PG8_SA
#undef PG8_SB
#undef PG8_STAGE
#undef PG8_LDA
#undef PG8_LDB
#undef PG8_MMA
#undef PG8_WAIT_V
#undef PG8_WAIT_L
#undef PG8_WAIT_VN
#undef PG8_BAR
#undef PG8_SCHED
}
}

constexpr size_t MiB = 1u << 20;
constexpr size_t WS_CTL = 0, CTL_ZERO_BYTES = 256 * 1024;
constexpr size_t WS_LOGF = 4 * MiB;
constexpr size_t WS_FL = 5 * MiB;
constexpr size_t WS_KMEAN = 6 * MiB;
constexpr size_t WS_RE = 7 * MiB;
constexpr size_t WS_RG = 7 * MiB + 256 * 1024;
constexpr size_t WS_RR = 7 * MiB + 512 * 1024;
constexpr size_t WS_POS = 7 * MiB + 768 * 1024;
constexpr size_t WS_CNT = 8 * MiB;
constexpr size_t WS_PB = 8 * MiB + 64 * 1024;
constexpr size_t WS_W = 16 * MiB;
constexpr size_t WS_XB = 192 * MiB;
constexpr size_t WS_BIG = 256 * MiB;
constexpr size_t WS_XS = 718 * MiB;
constexpr size_t WS_END = 850 * MiB;
static_assert(WS_BIG + (size_t)MAXROWS * FF * 2 <= WS_XS && WS_XS + (size_t)MAXROWS * DM * 2 <= WS_END, "d_ws map");
constexpr size_t WE_IN = 0, WE_OUT = 4 * MiB, WE_GU = 6 * MiB, WE_DN = 20 * MiB, WE_POOL = 27 * MiB;
constexpr size_t WO_IN = 28 * MiB, WO_OUT = 34 * MiB, WO_GU = 36 * MiB, WO_DN = 92 * MiB;
constexpr float S8_X = 16.f, S8_WGU = 256.f, S8_H = 8.f, S8_WDN = 1024.f;
constexpr size_t BG_HC = 0, BG_CAT = 192 * MiB, BG_HID = 0, BG_XS8 = 320 * MiB, BG_XB8 = 128 * MiB;
constexpr int CW_BAR = 1024;

constexpr int RING_BYTES = 131072;
constexpr int MISC_OFF = RING_BYTES;
constexpr int LDS_BYTES = 147456;

typedef GAS unsigned gu32;
#define RLX_AGENT __ATOMIC_RELAXED, __HIP_MEMORY_SCOPE_AGENT
#define LDS_WAIT() asm volatile("s_waitcnt lgkmcnt(0)" ::: "memory")
#define XB_TMO      128
#define XB_XCNT(j)  (256  + 64 * (j))
#define XB_XSUB(j)  (1280 + 64 * (j))
#define XB_XGEN(j)  (2304 + 64 * (j))
#define XB_TOP      3328
#define XB_TOPGEN   3392
#define XCD_BAR_WORDS 3456
#define XB_SPIN_CAP (1u << 18)

__device__ __forceinline__ unsigned xb_ld(unsigned* p)              { return __hip_atomic_load(p, __ATOMIC_RELAXED, __HIP_MEMORY_SCOPE_AGENT); }
__device__ __forceinline__ unsigned xb_add(unsigned* p, unsigned v) { return __hip_atomic_fetch_add(p, v, __ATOMIC_RELAXED, __HIP_MEMORY_SCOPE_AGENT); }
__device__ __forceinline__ unsigned xb_xcc_id() { return (unsigned)__builtin_amdgcn_s_getreg((3 << 11) | 20) & 0xFu; }
#define XB_SPIN(cond, bar) do { unsigned _sp = 0; while (cond) { __builtin_amdgcn_s_sleep(1); \
    if ((++_sp & 255u) == 0u) { if (xb_ld(&(bar)[XB_TMO])) break; if (_sp > XB_SPIN_CAP) { atomicAdd(&(bar)[XB_TMO], 1u); break; } } } } while (0)

struct XcdBarrier {
    unsigned* bar; unsigned x;
    volatile LAS unsigned* st;
};

__device__ __forceinline__ XcdBarrier xcd_barrier_post(unsigned* bar, volatile LAS unsigned* st) {
    XcdBarrier b; b.bar = bar; b.x = xb_xcc_id(); b.st = st;
    if (threadIdx.x == 0) (void)xb_add(&bar[XB_XCNT(b.x)], 1u);
    return b;
}
__device__ __forceinline__ void xcd_barrier_complete(unsigned* bar, unsigned x, unsigned& nloc, unsigned& nx) {
    const unsigned G = gridDim.x * gridDim.y * gridDim.z;
    unsigned sum, cnt, mine, sp = 0u;
    for (;;) {
        sum = 0u; cnt = 0u; mine = 0u;
#pragma unroll
        for (unsigned j = 0; j < 16; ++j) { const unsigned c = xb_ld(&bar[XB_XCNT(j)]); sum += c; cnt += (c > 0u) ? 1u : 0u; mine = (j == x) ? c : mine; }
        if (sum == G) break;
        __builtin_amdgcn_s_sleep(1);
        if ((++sp & 255u) == 0u) { if (xb_ld(&bar[XB_TMO])) break; if (sp > XB_SPIN_CAP) { atomicAdd(&bar[XB_TMO], 1u); break; } }
    }
    nloc = mine > 0u ? mine : 1u; nx = cnt > 0u ? cnt : 1u;
}

__device__ __forceinline__ void xcd_barrier(const XcdBarrier& b) {
    asm volatile("s_waitcnt vmcnt(0)" ::: "memory");
    __syncthreads();
    if (threadIdx.x == 0) {
        unsigned* bar = b.bar;
        __builtin_amdgcn_s_waitcnt(0);
        unsigned nloc = b.st[0], nx = b.st[1];
        if (nloc == 0u) { xcd_barrier_complete(bar, b.x, nloc, nx); b.st[0] = nloc; b.st[1] = nx; }
        const unsigned old = xb_add(&bar[XB_XSUB(b.x)], 1u);
        const unsigned gen = old / nloc;
        if (old + 1u == (gen + 1u) * nloc) {
            __builtin_amdgcn_fence(__ATOMIC_RELEASE, "agent");
            asm volatile("s_waitcnt vmcnt(0)" ::: "memory");
            const unsigned og = xb_add(&bar[XB_TOP], 1u);
            const unsigned tg = og / nx;
            if (og + 1u == (tg + 1u) * nx) xb_add(&bar[XB_TOPGEN], 1u);
            else XB_SPIN(xb_ld(&bar[XB_TOPGEN]) == tg, bar);
            __builtin_amdgcn_fence(__ATOMIC_ACQUIRE, "agent");
            xb_add(&bar[XB_XGEN(b.x)], 1u);
            asm volatile("s_waitcnt vmcnt(0)" ::: "memory");
        } else {
            XB_SPIN(xb_ld(&bar[XB_XGEN(b.x)]) == gen, bar);
            __builtin_amdgcn_fence(__ATOMIC_ACQUIRE, "agent");
            asm volatile("s_waitcnt vmcnt(0)" ::: "memory");
        }
    }
    __syncthreads();
}

__device__ __forceinline__ float wave_sum(float v, int lane) {
#pragma unroll
    for (int o = 1; o < 64; o <<= 1) v += lane_xor(v, lane, o);
    return v;
}
__device__ __forceinline__ void transpose_item(const float* W, int K, int ld, int col0, int N, bf16_t* WT, int mode, int rowoff, const float* scale, LAS float* scr, int item, int lane) {
    const int nblk = N / 32, kb = item / nblk, nb = item % nblk, k0 = 64 * kb, n0 = 32 * nb;
    float tv[32];
#pragma unroll
    for (int i = 0; i < 32; ++i) { const int kk = 2 * i + (lane >> 5); tv[i] = __builtin_nontemporal_load(W + (size_t)(k0 + kk) * ld + col0 + n0 + (lane & 31)); }
    __builtin_amdgcn_sched_barrier(0);
#pragma unroll
    for (int i = 0; i < 32; ++i) { const int kk = 2 * i + (lane >> 5); scr[kk * 33 + (lane & 31)] = tv[i]; }
    LDS_WAIT(); asm volatile("" ::: "memory");
    const int c = lane & 7;
    const int r0 = (mode == 0) ? (rowoff + n0) : (256 * (n0 >> 7) + (n0 & 127) + rowoff);
#pragma unroll
    for (int j = 0; j < 4; ++j) { const int n = (lane >> 3) + 8 * j; const LAS float* s = scr + (8 * c) * 33 + n;
        const float sc = scale ? scale[n0 + n] : 1.f;
        u32x4 o; o.x = cvt_pk_bf16(s[0 * 33] * sc, s[1 * 33] * sc); o.y = cvt_pk_bf16(s[2 * 33] * sc, s[3 * 33] * sc); o.z = cvt_pk_bf16(s[4 * 33] * sc, s[5 * 33] * sc); o.w = cvt_pk_bf16(s[6 * 33] * sc, s[7 * 33] * sc);
        *(u32x4*)(WT + (size_t)(r0 + n) * K + k0 + 8 * c) = o; }
    LDS_WAIT(); asm volatile("" ::: "memory");
}
constexpr int T8_PITCH = 136;
__device__ __forceinline__ void transpose_item8(const float* W, int K, int ld, int N, unsigned char* WT, int mode, int rowoff, float mul, LAS unsigned char* scr, int item, int lane) {
    const int nblk = N / 64, kb = item / nblk, nb = item % nblk, k0 = 128 * kb, n0 = 64 * nb;
    const int g = lane >> 4, l16 = lane & 15;
    const float* src = W + (size_t)(k0 + 2 * g) * ld + n0 + 4 * l16;
    f32x4 ra[16], rb[16];
#pragma unroll
    for (int it = 0; it < 16; ++it) { ra[it] = __builtin_nontemporal_load((const f32x4*)(src + (size_t)(8 * it) * ld)); rb[it] = __builtin_nontemporal_load((const f32x4*)(src + (size_t)(8 * it + 1) * ld)); }
    __builtin_amdgcn_sched_barrier(0);
#pragma unroll
    for (int it = 0; it < 16; ++it) {
        const f32x4 a = ra[it] * mul, b = rb[it] * mul;
        int w0 = 0, w1 = 0;
        w0 = __builtin_amdgcn_cvt_pk_fp8_f32(pg8::clamp448(a.x), pg8::clamp448(b.x), w0, false); w0 = __builtin_amdgcn_cvt_pk_fp8_f32(pg8::clamp448(a.y), pg8::clamp448(b.y), w0, true);
        w1 = __builtin_amdgcn_cvt_pk_fp8_f32(pg8::clamp448(a.z), pg8::clamp448(b.z), w1, false); w1 = __builtin_amdgcn_cvt_pk_fp8_f32(pg8::clamp448(a.w), pg8::clamp448(b.w), w1, true);
        *(LAS u32x2*)(scr + (4 * it + g) * T8_PITCH + l16 * 8) = (u32x2){(unsigned)w0, (unsigned)w1};
    }
    LDS_WAIT(); asm volatile("" ::: "memory");
    const int r0 = (mode == 0) ? (rowoff + n0) : (256 * (n0 >> 7) + (n0 & 127) + rowoff);
    const LAS unsigned char* rd = scr + (l16 >> 2) * T8_PITCH + (l16 & 3) * 8;
#pragma unroll
    for (int t = 0; t < 8; ++t) { const int cb = t >> 1, piece = (t & 1) * 4 + g;
        const LAS unsigned char* p = rd + (piece * 8) * T8_PITCH + cb * 32;
        const s16x4 lo = __builtin_bit_cast(s16x4, __builtin_amdgcn_ds_read_tr16_b64_v4i16((LAS s16x4*)p)), hi = __builtin_bit_cast(s16x4, __builtin_amdgcn_ds_read_tr16_b64_v4i16((LAS s16x4*)(p + 4 * T8_PITCH)));
        const u32x2 l2 = __builtin_bit_cast(u32x2, lo), h2 = __builtin_bit_cast(u32x2, hi);
        *(u32x4*)(WT + (size_t)(r0 + cb * 16 + l16) * K + k0 + piece * 16) = (u32x4){l2.x, l2.y, h2.x, h2.y}; }
    LDS_WAIT(); asm volatile("" ::: "memory");
}
__device__ __forceinline__ void conv_job8(const float* W, size_t wstride, int K, int ld, int N, unsigned char* WT, size_t tstride, int mode, int rowoff, float mul, int nbatch,
                                          LAS unsigned char* scr, int gw, int NGW, int lane, int& base) {
    const int per = (K / 128) * (N / 64), total = per * nbatch;
    int first = (gw - base) % NGW; if (first < 0) first += NGW;
    for (int it = first; it < total; it += NGW) { const int bi = it / per, r = it - bi * per;
        transpose_item8(W + bi * wstride, K, ld, N, WT + bi * tstride, mode, rowoff, mul, scr, r, lane); }
    base = (base + total) % NGW;
}
__device__ __forceinline__ void conv_job(const float* W, size_t wstride, int K, int ld, int col0, int N, bf16_t* WT, size_t tstride, int mode, int rowoff, const float* scale, size_t sstride, int nbatch,
                                         LAS float* scr, int gw, int NGW, int lane, int& base) {
    const int per = (K / 64) * (N / 32), total = per * nbatch;
    int first = (gw - base) % NGW; if (first < 0) first += NGW;
    for (int it = first; it < total; it += NGW) { const int bi = it / per, r = it - bi * per;
        transpose_item(W + bi * wstride, K, ld, col0, N, WT + bi * tstride, mode, rowoff, scale ? scale + bi * sstride : nullptr, scr, r, lane); }
    base = (base + total) % NGW;
}

__device__ __forceinline__ float wave_sum_dpp(float v) {
    v += __int_as_float(__builtin_amdgcn_update_dpp(0, __float_as_int(v), 0xB1, 0xf, 0xf, false));
    v += __int_as_float(__builtin_amdgcn_update_dpp(0, __float_as_int(v), 0x4E, 0xf, 0xf, false));
    v += __int_as_float(__builtin_amdgcn_update_dpp(0, __float_as_int(v), 0x141, 0xf, 0xf, false));
    v += __int_as_float(__builtin_amdgcn_update_dpp(0, __float_as_int(v), 0x140, 0xf, 0xf, false));
    { auto r = __builtin_amdgcn_permlane16_swap(__float_as_uint(v), __float_as_uint(v), false, false); v = __uint_as_float(r[0]) + __uint_as_float(r[1]); }
    { auto r = __builtin_amdgcn_permlane32_swap(__float_as_uint(v), __float_as_uint(v), false, false); v = __uint_as_float(r[0]) + __uint_as_float(r[1]); }
    return v;
}
enum { RP_LN = 1, RP_COMBINE = 2, RP_FORGET = 4, RP_ROUTER = 8, RP_WRITE_XF = 16, RP_SRC_BF16 = 32, RP_WRITE_X8 = 64 };
template <int FLAGS>
__device__ __forceinline__ void row_phase(LAS unsigned char* lds, int chunk,
        const float* src, float* XF, bf16_t* XB, const float* gam, const float* bet,
        const float* w8, int w8ld, const float* bfg, float* LOGF,
        const bf16_t* YB, const f32x2* RG_in, const i32x2* POS_in,
        unsigned* RE, f32x2* RG, unsigned* RR, int* CNT, unsigned char* X8 = nullptr) {
    constexpr int RB = ((FLAGS & RP_COMBINE) && (FLAGS & RP_FORGET)) ? 2 : 4;
    const int tid = fresh_tid(), lane = tid & 63, wave = __builtin_amdgcn_readfirstlane(tid >> 6);
    LAS float* w8s = (LAS float*)lds;
    volatile LAS int* hist = (volatile LAS int*)(lds + MISC_OFF + 64);
    if (FLAGS & (RP_FORGET | RP_ROUTER)) {
        float wt[16];
#pragma unroll
        for (int j = 0; j < 16; ++j) { const int i = tid + 512 * j; wt[j] = w8[(size_t)(i >> 3) * w8ld + (i & 7)]; }
        __builtin_amdgcn_sched_barrier(0);
#pragma unroll
        for (int j = 0; j < 16; ++j) { const int i = tid + 512 * j; w8s[(i & 7) * 1024 + (i >> 3)] = wt[j]; }
        if (tid < 8) hist[tid] = 0;
        __syncthreads();
    }
    f32x4 gv[4], bv[4];
    if (FLAGS & RP_LN) {
#pragma unroll
        for (int j = 0; j < 4; ++j) { gv[j] = ((const f32x4*)gam)[lane + 64 * j]; bv[j] = ((const f32x4*)bet)[lane + 64 * j]; }
    }
    for (int it = 0; it < 16 / RB; ++it) {
        const int m0 = chunk * 128 + wave * 16 + it * RB;
        f32x4 v[RB][4]; u32x2 raw[RB][4]; u32x2 ya[RB][4], yb[RB][4]; f32x2 gg[RB];
        if (FLAGS & RP_COMBINE) {
            i32x2 pp[RB];
#pragma unroll
            for (int r = 0; r < RB; ++r) { gg[r] = RG_in[m0 + r]; pp[r] = POS_in[m0 + r]; }
#pragma unroll
            for (int r = 0; r < RB; ++r) { const u32x2* y0 = (const u32x2*)(YB + (size_t)pp[r].x * DM); const u32x2* y1 = (const u32x2*)(YB + (size_t)pp[r].y * DM);
#pragma unroll
                for (int j = 0; j < 4; ++j) { ya[r][j] = __builtin_nontemporal_load(y0 + lane + 64 * j); yb[r][j] = __builtin_nontemporal_load(y1 + lane + 64 * j); } }
        }
        if (FLAGS & RP_SRC_BF16) {
#pragma unroll
            for (int r = 0; r < RB; ++r)
#pragma unroll
                for (int j = 0; j < 4; ++j) raw[r][j] = __builtin_nontemporal_load((const u32x2*)((const bf16_t*)src + (size_t)(m0 + r) * DM) + lane + 64 * j);
        } else {
#pragma unroll
            for (int r = 0; r < RB; ++r)
#pragma unroll
                for (int j = 0; j < 4; ++j) v[r][j] = __builtin_nontemporal_load((const f32x4*)(src + (size_t)(m0 + r) * DM) + lane + 64 * j);
        }
        __builtin_amdgcn_sched_barrier(0);
        if (FLAGS & RP_SRC_BF16) {
#pragma unroll
            for (int r = 0; r < RB; ++r)
#pragma unroll
                for (int j = 0; j < 4; ++j) { const u32x2 w = raw[r][j]; v[r][j] = (f32x4){bf_lo(w.x), bf_hi(w.x), bf_lo(w.y), bf_hi(w.y)}; }
        }
        if (FLAGS & RP_COMBINE) {
#pragma unroll
            for (int r = 0; r < RB; ++r)
#pragma unroll
                for (int j = 0; j < 4; ++j) { const u32x2 a = ya[r][j], b = yb[r][j];
                    const f32x4 fa = {bf_lo(a.x), bf_hi(a.x), bf_lo(a.y), bf_hi(a.y)}, fb = {bf_lo(b.x), bf_hi(b.x), bf_lo(b.y), bf_hi(b.y)};
                    v[r][j] = v[r][j] * ALPHA + (fa * gg[r].x + fb * gg[r].y); }
        }
        if (FLAGS & RP_LN) {
            float mean[RB], rstd[RB];
#pragma unroll
            for (int r = 0; r < RB; ++r) { float s = 0.f;
#pragma unroll
                for (int j = 0; j < 4; ++j) s += (v[r][j].x + v[r][j].y) + (v[r][j].z + v[r][j].w);
                mean[r] = wave_sum_dpp(s) * (1.f / DM); }
#pragma unroll
            for (int r = 0; r < RB; ++r) { float s2 = 0.f;
#pragma unroll
                for (int j = 0; j < 4; ++j) { v[r][j] = v[r][j] - mean[r]; s2 += (v[r][j].x * v[r][j].x + v[r][j].y * v[r][j].y) + (v[r][j].z * v[r][j].z + v[r][j].w * v[r][j].w); }
                rstd[r] = 1.f / sqrtf(wave_sum_dpp(s2) * (1.f / DM) + LN_EPS); }
#pragma unroll
            for (int r = 0; r < RB; ++r)
#pragma unroll
                for (int j = 0; j < 4; ++j) v[r][j] = v[r][j] * rstd[r] * gv[j] + bv[j];
        }
#pragma unroll
        for (int r = 0; r < RB; ++r) {
            if (FLAGS & RP_WRITE_XF) {
#pragma unroll
                for (int j = 0; j < 4; ++j) ((f32x4*)(XF + (size_t)(m0 + r) * DM))[lane + 64 * j] = v[r][j];
            }
            u32x2* o8 = (u32x2*)(XB + (size_t)(m0 + r) * DM);
#pragma unroll
            for (int j = 0; j < 4; ++j) { u32x2 w; w.x = cvt_pk_bf16(v[r][j].x, v[r][j].y); w.y = cvt_pk_bf16(v[r][j].z, v[r][j].w); o8[lane + 64 * j] = w; }
            if (FLAGS & RP_WRITE_X8) { unsigned* o1 = (unsigned*)(X8 + (size_t)(m0 + r) * DM);
#pragma unroll
                for (int j = 0; j < 4; ++j) o1[lane + 64 * j] = pg8::pack4_fp8(v[r][j].x * S8_X, v[r][j].y * S8_X, v[r][j].z * S8_X, v[r][j].w * S8_X); }
        }
        if (FLAGS & (RP_FORGET | RP_ROUTER)) {
            float d[RB][8];
#pragma unroll
            for (int e = 0; e < 8; ++e) { f32x4 w[4];
#pragma unroll
                for (int j = 0; j < 4; ++j) w[j] = ((const LAS f32x4*)(w8s + e * 1024))[lane + 64 * j];
#pragma unroll
                for (int r = 0; r < RB; ++r) { float a = 0.f;
#pragma unroll
                    for (int j = 0; j < 4; ++j) a += (v[r][j].x * w[j].x + v[r][j].y * w[j].y) + (v[r][j].z * w[j].z + v[r][j].w * w[j].w);
                    d[r][e] = wave_sum_dpp(a); } }
#pragma unroll
            for (int r = 0; r < RB; ++r) {
                const int m = m0 + r;
                if (FLAGS & RP_FORGET) {
                    float lg[8];
#pragma unroll
                    for (int e = 0; e < 8; ++e) { const float z = d[r][e] + bfg[e]; lg[e] = fminf(z, 0.f) - 0.6931471805599453f * __builtin_amdgcn_logf(1.0f + __builtin_amdgcn_exp2f(-fabsf(z) * LOG2E)); }
                    if (lane == 0) { f32x4* dst = (f32x4*)(LOGF + (size_t)m * 8); dst[0] = (f32x4){lg[0], lg[1], lg[2], lg[3]}; dst[1] = (f32x4){lg[4], lg[5], lg[6], lg[7]}; }
                }
                if (FLAGS & RP_ROUTER) {
                    float v0 = -INFINITY, v1 = -INFINITY; int i0 = 0, i1 = 0;
#pragma unroll
                    for (int e = 0; e < 8; ++e) { const float x = d[r][e];
                        if (x > v0) { v1 = v0; i1 = i0; v0 = x; i0 = e; } else if (x > v1) { v1 = x; i1 = e; } }
                    if (lane == 0) {
                        const float ex = __builtin_amdgcn_exp2f((v1 - v0) * LOG2E), inv = 1.f / (1.f + ex);
                        const int r0 = __hip_atomic_fetch_add((LAS int*)(lds + MISC_OFF + 64) + i0, 1, __ATOMIC_RELAXED, __HIP_MEMORY_SCOPE_WORKGROUP), r1 = __hip_atomic_fetch_add((LAS int*)(lds + MISC_OFF + 64) + i1, 1, __ATOMIC_RELAXED, __HIP_MEMORY_SCOPE_WORKGROUP);
                        RE[m] = (unsigned)i0 | ((unsigned)i1 << 8); RR[m] = (unsigned)r0 | ((unsigned)r1 << 16); RG[m] = (f32x2){inv, ex * inv};
                    }
                }
            }
        }
    }
    if (FLAGS & RP_ROUTER) { __syncthreads(); if (tid < 8) CNT[chunk * 8 + tid] = hist[tid]; }
    __syncthreads();
}

__device__ __forceinline__ void fox_scan(LAS unsigned char* lds, int bh, const float* LOGF, float* FL) {
    const int tid = fresh_tid(), lane = tid & 63, wave = __builtin_amdgcn_readfirstlane(tid >> 6);
    LAS float* wtot = (LAS float*)lds;
    const int b = bh >> 3, h = bh & 7;
    float x[8]; float run = 0.f;
#pragma unroll
    for (int i = 0; i < 8; ++i) { run += LOGF[((size_t)b * SEQ + 8 * tid + i) * 8 + h]; x[i] = run; }
    float inc = run;
#pragma unroll
    for (int o = 1; o < 64; o <<= 1) { const float y = __int_as_float(__builtin_amdgcn_ds_bpermute((lane - o) << 2, __float_as_int(inc))); if (lane >= o) inc += y; }
    if (lane == 63) wtot[wave] = inc;
    __syncthreads();
    float pre = inc - run;
#pragma unroll
    for (int w = 0; w < 8; ++w) { const float t = wtot[w]; if (w < wave) pre += t; }
    f32x4 o0 = {(pre + x[0]) * LOG2E, (pre + x[1]) * LOG2E, (pre + x[2]) * LOG2E, (pre + x[3]) * LOG2E}, o1 = {(pre + x[4]) * LOG2E, (pre + x[5]) * LOG2E, (pre + x[6]) * LOG2E, (pre + x[7]) * LOG2E};
    f32x4* dst = (f32x4*)(FL + (size_t)bh * SEQ + 8 * tid); dst[0] = o0; dst[1] = o1;
    __syncthreads();
}

__device__ __forceinline__ void kmean_unit(LAS unsigned char* lds, int c, const bf16_t* Kp  , float* KMEAN) {
    const int tid = fresh_tid(), lane = tid & 63, wave = __builtin_amdgcn_readfirstlane(tid >> 6);
    const int bn = c >> 1, col0 = 512 * (c & 1);
    const bf16_t* p = Kp + ((size_t)bn * 256 + 32 * wave) * 3072 + col0 + 8 * lane;
    float a[8];
#pragma unroll
    for (int j = 0; j < 8; ++j) a[j] = 0.f;
    u32x4 kw[32];
#pragma unroll
    for (int r = 0; r < 32; ++r) kw[r] = *(const u32x4*)(p + (size_t)r * 3072);
    __builtin_amdgcn_sched_barrier(0);
#pragma unroll
    for (int r = 0; r < 32; ++r) { const u32x4 w = kw[r];
        a[0] += bf_lo(w.x); a[1] += bf_hi(w.x); a[2] += bf_lo(w.y); a[3] += bf_hi(w.y); a[4] += bf_lo(w.z); a[5] += bf_hi(w.z); a[6] += bf_lo(w.w); a[7] += bf_hi(w.w); }
    LAS float* red = (LAS float*)lds;
    *(LAS f32x4*)(red + wave * 512 + 8 * lane) = (f32x4){a[0], a[1], a[2], a[3]}; *(LAS f32x4*)(red + wave * 512 + 8 * lane + 4) = (f32x4){a[4], a[5], a[6], a[7]};
    __syncthreads();
    float s = 0.f;
#pragma unroll
    for (int w = 0; w < 8; ++w) s += red[w * 512 + tid];
    KMEAN[(size_t)bn * 1024 + col0 + tid] = s * (1.f / 256.f);
    __syncthreads();
}

__device__ __forceinline__ void moe_sort(LAS unsigned char* lds, int chunk, const int* CNT, const unsigned* RE, const unsigned* RR, const bf16_t* XB, unsigned char* XS8, i32x2* POS, int* PB) {
    const int tid = fresh_tid(), lane = tid & 63, wave = __builtin_amdgcn_readfirstlane(tid >> 6);
    LAS int* tbl = (LAS int*)lds;
    LAS int* tot = (LAS int*)(lds + 8192);
    for (int i = tid; i < 2048; i += 512) tbl[i] = CNT[i];
    __syncthreads();
    { const int e = wave; float t = 0.f, before = 0.f;
#pragma unroll
      for (int j = 0; j < 4; ++j) { const int c = 4 * lane + j; const float v = (float)tbl[c * 8 + e]; t += v; before += (c < chunk) ? v : 0.f; }
      t = wave_sum_dpp(t); before = wave_sum_dpp(before);
      if (lane == 0) { tot[e] = (int)t; tot[8 + e] = (int)before; } }
    __syncthreads();
    if (tid == 0) { int pb = 0; for (int e = 0; e < 8; ++e) { tot[16 + e] = pb * 256 + tot[8 + e]; pb += (tot[e] + 255) >> 8; tot[24 + e] = pb; } if (chunk == 0) PB[8] = pb; }
    __syncthreads();
    if (chunk == 0 && tid < tot[31]) { int e = 0;
#pragma unroll
        for (int k = 0; k < 7; ++k) e += (tid >= tot[24 + k]) ? 1 : 0;
        PB[16 + tid] = e; }
#pragma unroll 1
    for (int it = 0; it < 4; ++it) {
        const int m0 = chunk * 128 + wave * 16 + it * 4;
        unsigned e[4], r[4]; u32x2 xw[4][4];
#pragma unroll
        for (int q = 0; q < 4; ++q) { e[q] = RE[m0 + q]; r[q] = RR[m0 + q];
#pragma unroll
            for (int j = 0; j < 4; ++j) xw[q][j] = ((const u32x2*)(XB + (size_t)(m0 + q) * DM))[lane + 64 * j]; }
#pragma unroll
        for (int q = 0; q < 4; ++q) {
            const int p0 = tot[16 + (e[q] & 0xff)] + (int)(r[q] & 0xffff), p1 = tot[16 + (e[q] >> 8)] + (int)(r[q] >> 16);
            unsigned* d0 = (unsigned*)(XS8 + (size_t)p0 * DM); unsigned* d1 = (unsigned*)(XS8 + (size_t)p1 * DM);
#pragma unroll
            for (int j = 0; j < 4; ++j) { const u32x2 x = xw[q][j]; const unsigned w = pg8::pack4_fp8(bf_lo(x.x) * S8_X, bf_hi(x.x) * S8_X, bf_lo(x.y) * S8_X, bf_hi(x.y) * S8_X); d0[lane + 64 * j] = w; d1[lane + 64 * j] = w; }
            if (lane == 0) POS[m0 + q] = (i32x2){p0, p1};
        }
    }
    __syncthreads();
}

constexpr float AT_THR = 6.0f;
constexpr float AT_PRUNE = 48.0f;
__device__ __forceinline__ float half_sum(float v) { auto r = __builtin_amdgcn_permlane32_swap(__float_as_uint(v), __float_as_uint(v), false, false); return __uint_as_float(r[0]) + __uint_as_float(r[1]); }
__device__ __forceinline__ float half_max(float v) { auto r = __builtin_amdgcn_permlane32_swap(__float_as_uint(v), __float_as_uint(v), false, false); return fmaxf(__uint_as_float(r[0]), __uint_as_float(r[1])); }
__device__ __forceinline__ int crow(int r, int hi) { return (r & 3) + 8 * (r >> 2) + 4 * hi; }
__device__ __forceinline__ s16x4 vtr(const LAS unsigned char* p) { return __builtin_bit_cast(s16x4, __builtin_amdgcn_ds_read_tr16_b64_v4i16((LAS s16x4*)p)); }

constexpr int PL_PITCH = 272;
template <int W>
__device__ __forceinline__ void pool_mix(LAS unsigned char* lds, int tid, const bf16_t* up, int tseq0) {
    const int cp = tid & 63, i0 = 32 * (tid >> 6);
    const bf16_t* src = up + 2 * cp;
    unsigned uu[32 + W - 1];
#pragma unroll
    for (int k = 0; k < 32 + W - 1; ++k) { const int i = i0 - (W - 1) + k; uu[k] = (tseq0 + i >= 0) ? *(const unsigned*)(src + (long)i * 2048) : 0u; }
    float s0 = 0.f, s1 = 0.f;
#pragma unroll
    for (int k = 0; k < W - 1; ++k) { s0 += bf_lo(uu[k]); s1 += bf_hi(uu[k]); }
#pragma unroll
    for (int r = 0; r < 32; ++r) { const unsigned x = uu[r + W - 1]; const float a = bf_lo(x), b = bf_hi(x); s0 += a; s1 += b;
        const int t = tseq0 + i0 + r; const float icnt = __builtin_amdgcn_rcpf((float)((t + 1 < W) ? (t + 1) : W));
        *(LAS unsigned*)(lds + (i0 + r) * PL_PITCH + cp * 4) = cvt_pk_bf16(s0 * icnt - a, s1 * icnt - b);
        s0 -= bf_lo(uu[r]); s1 -= bf_hi(uu[r]); }
}
__device__ __forceinline__ void pool_unit(LAS unsigned char* lds, int pm, int g, const bf16_t* HC  , const bf16_t* WP  , bf16_t* CAT  ) {
    const int tid = fresh_tid(), lane = tid & 63, wv = __builtin_amdgcn_readfirstlane(tid >> 6), fr = lane & 15, fq = lane >> 4;
    const int row0 = pm * 256, tseq0 = row0 & (SEQ - 1);
    { const bf16_t* up = HC + (size_t)row0 * 2048 + 1536 + 128 * g;
      if (g == 0) pool_mix<2>(lds, tid, up, tseq0); else if (g == 1) pool_mix<4>(lds, tid, up, tseq0); else if (g == 2) pool_mix<8>(lds, tid, up, tseq0); else pool_mix<16>(lds, tid, up, tseq0); }
    const bf16_t* wp = WP + (size_t)g * 16384;
    bf16x8 bw[4][8];
#pragma unroll
    for (int ks = 0; ks < 4; ++ks)
#pragma unroll
        for (int n = 0; n < 8; ++n) bw[ks][n] = *(const bf16x8*)(wp + (16 * n + fr) * 128 + 32 * ks + 8 * fq);
    __builtin_amdgcn_sched_barrier(0);
    __syncthreads();
    f32x4 acc[2][8];
#pragma unroll
    for (int m = 0; m < 2; ++m)
#pragma unroll
        for (int n = 0; n < 8; ++n) acc[m][n] = (f32x4){0.f, 0.f, 0.f, 0.f};
#pragma unroll
    for (int ks = 0; ks < 4; ++ks) {
        bf16x8 a[2];
#pragma unroll
        for (int m = 0; m < 2; ++m) a[m] = *(const LAS bf16x8*)(lds + (32 * wv + 16 * m + fr) * PL_PITCH + (32 * ks + 8 * fq) * 2);
#pragma unroll
        for (int n = 0; n < 8; ++n) {
            const bf16x8 bfrag = bw[ks][n];
#pragma unroll
            for (int m = 0; m < 2; ++m) acc[m][n] = __builtin_amdgcn_mfma_f32_16x16x32_bf16(bfrag, a[m], acc[m][n], 0, 0, 0); }
    }
#pragma unroll
    for (int m = 0; m < 2; ++m) { bf16_t* orow = CAT + (size_t)(row0 + 32 * wv + 16 * m + fr) * 1024 + 512 + 128 * g + 4 * fq;
#pragma unroll
        for (int n = 0; n < 8; ++n) { u32x2 o; o.x = cvt_pk_bf16(acc[m][n][0], acc[m][n][1]); o.y = cvt_pk_bf16(acc[m][n][2], acc[m][n][3]); *(u32x2*)(orow + 16 * n) = o; } }
    __syncthreads();
}

constexpr int MB_CAPR = 5888;
constexpr int MB_KB = 0, MB_VB = 32768, MB_WS = 65536, MB_KM = 73728, MB_CNT = 77824, MB_LIST = 78080, MB_PK = 90112, MB_END = MB_PK + 2304 * 3 * 4;
static_assert(MB_LIST + MB_CAPR * 2 <= MB_PK && MB_END <= RING_BYTES, "MoBA LDS map");

__device__ __forceinline__ void moba_issue_block(u32x4 (&kr)[4], u32x4 (&vr)[4], int lane, int wid, const bf16_t* Kblk, const bf16_t* Vblk, int pitch) {
    const bf16_t* ksrc = Kblk + (size_t)lane * pitch + wid * 8;
    const bf16_t* vsrc = Vblk + (size_t)(16 * (wid & 3) + (lane >> 2)) * pitch + (wid >> 2) * 32 + (lane & 3) * 8;
#pragma unroll
    for (int j = 0; j < 4; ++j) { kr[j] = *(const u32x4*)(ksrc + (size_t)j * 64 * pitch); vr[j] = *(const u32x4*)(vsrc + (size_t)j * 64 * pitch); }
}
__device__ __forceinline__ void moba_commit_block(LAS unsigned char* lds, const u32x4 (&kr)[4], const u32x4 (&vr)[4], int lane, int wid) {
    const int stoff = wid * 1024 + lane * 16;
#pragma unroll
    for (int j = 0; j < 4; ++j) { *(LAS u32x4*)(lds + MB_KB + j * 8192 + stoff) = kr[j]; *(LAS u32x4*)(lds + MB_VB + j * 8192 + stoff) = vr[j]; }
}
template <bool CAUSAL>
__device__ __forceinline__ void moba_block(LAS unsigned char* lds, int lane, int wid, int r32, int hi, const bf16x8 (&qr)[4], int qrel, int qmax, float& mhat, float& lsum, f32x16& o0, f32x16& o1) {
    LAS float* wsf = (LAS float*)(lds + MB_WS) + wid * 256;
    const int kfo = hi * 1024 + r32 * 16;
    const int vfo = ((lane >> 4) & 1) * 32 + (lane & 3) * 8 + (4 * hi + ((lane & 15) >> 2)) * 64;
#pragma unroll 1
    for (int t = 0; t < 4; ++t) {
        if (CAUSAL) { if (64 * t > qmax) break; }
        {
            const LAS unsigned char* kb_ = lds + MB_KB + t * 8192 + kfo;
            f32x16 p0 = {}, p1 = {};
bf16x8 kf[8];
#pragma unroll
            for (int d0 = 0; d0 < 4; ++d0) { kf[2 * d0] = *(const LAS bf16x8*)(kb_ + d0 * 2048); kf[2 * d0 + 1] = *(const LAS bf16x8*)(kb_ + d0 * 2048 + 512); }
            __builtin_amdgcn_sched_barrier(0);
#pragma unroll
            for (int d0 = 0; d0 < 4; ++d0) { p0 = __builtin_amdgcn_mfma_f32_32x32x16_bf16(kf[2 * d0], qr[d0], p0, 0, 0, 0); p1 = __builtin_amdgcn_mfma_f32_32x32x16_bf16(kf[2 * d0 + 1], qr[d0], p1, 0, 0, 0); }
            s16x4 vlo[8], vhi[8];
            { const LAS unsigned char* vq_ = (lds + MB_VB + t * 8192 + vfo);
#pragma unroll
              for (int i = 0; i < 8; ++i) { vlo[i] = vtr(vq_ + (i & 1) * 4096 + (i >> 1) * 1024); vhi[i] = vtr(vq_ + (i & 1) * 4096 + (i >> 1) * 1024 + 512); } }
            __builtin_amdgcn_sched_barrier(0);
#pragma unroll
            for (int r = 0; r < 16; ++r) { p0[r] -= mhat; p1[r] -= mhat; }
            if (CAUSAL) { const int kbase = 64 * t + 4 * hi;
#pragma unroll
                for (int r = 0; r < 16; ++r) { const int kv = kbase + (r & 3) + 8 * (r >> 2); if (kv > qrel) p0[r] = -INFINITY; if (kv + 32 > qrel) p1[r] = -INFINITY; } }
#define MX3(a_, b_, c_) __builtin_fmaxf(__builtin_fmaxf((a_), (b_)), (c_))
            float ra = MX3(p0[0], p0[1], p1[0]), rb = MX3(p0[2], p0[3], p1[1]); ra = MX3(ra, p1[2], p1[3]);
#pragma unroll
            for (int r = 4; r < 16; r += 4) { ra = MX3(ra, p0[r], p0[r + 1]); rb = MX3(rb, p0[r + 2], p0[r + 3]); ra = MX3(ra, p1[r], p1[r + 1]); rb = MX3(rb, p1[r + 2], p1[r + 3]); }
#undef MX3
            const float rm = half_max(fmaxf(ra, rb));
            const bool mv = rm > AT_THR;
            if (__any(mv)) {
                const float dl = mv ? rm : 0.f, al = __builtin_amdgcn_exp2f(-dl); mhat += dl; lsum *= al;
#pragma unroll
                for (int r = 0; r < 16; ++r) { p0[r] -= dl; p1[r] -= dl; }
                if (hi == 0) wsf[r32] = al;
#pragma unroll
                for (int g = 0; g < 4; ++g) { const f32x4 a4 = *(const LAS f32x4*)(wsf + 8 * g + 4 * hi);
                    o0[4 * g + 0] *= a4.x; o0[4 * g + 1] *= a4.y; o0[4 * g + 2] *= a4.z; o0[4 * g + 3] *= a4.w; o1[4 * g + 0] *= a4.x; o1[4 * g + 1] *= a4.y; o1[4 * g + 2] *= a4.z; o1[4 * g + 3] *= a4.w; }
            }
            float ps = 0.f;
#pragma unroll
            for (int r = 0; r < 16; ++r) { p0[r] = __builtin_amdgcn_exp2f(p0[r]); p1[r] = __builtin_amdgcn_exp2f(p1[r]); ps += p0[r] + p1[r]; }
            lsum += ps;
            u32x4 pw0, pw1, pw2, pw3;
            pw0.x = cvt_pk_bf16(p0[0], p0[1]); pw0.y = cvt_pk_bf16(p0[2], p0[3]); pw0.z = cvt_pk_bf16(p0[4], p0[5]); pw0.w = cvt_pk_bf16(p0[6], p0[7]);
            pw1.x = cvt_pk_bf16(p0[8], p0[9]); pw1.y = cvt_pk_bf16(p0[10], p0[11]); pw1.z = cvt_pk_bf16(p0[12], p0[13]); pw1.w = cvt_pk_bf16(p0[14], p0[15]);
            pw2.x = cvt_pk_bf16(p1[0], p1[1]); pw2.y = cvt_pk_bf16(p1[2], p1[3]); pw2.z = cvt_pk_bf16(p1[4], p1[5]); pw2.w = cvt_pk_bf16(p1[6], p1[7]);
            pw3.x = cvt_pk_bf16(p1[8], p1[9]); pw3.y = cvt_pk_bf16(p1[10], p1[11]); pw3.z = cvt_pk_bf16(p1[12], p1[13]); pw3.w = cvt_pk_bf16(p1[14], p1[15]);
            __builtin_amdgcn_sched_barrier(0);
#define PV_STEP(OACC, I, PW) do { const bf16x8 vf_ = {vlo[I][0], vlo[I][1], vlo[I][2], vlo[I][3], vhi[I][0], vhi[I][1], vhi[I][2], vhi[I][3]}; \
                OACC = __builtin_amdgcn_mfma_f32_32x32x16_bf16(__builtin_bit_cast(bf16x8, PW), vf_, OACC, 0, 0, 0); } while (0)
            PV_STEP(o0, 0, pw0); PV_STEP(o1, 1, pw0); PV_STEP(o0, 2, pw1); PV_STEP(o1, 3, pw1);
            PV_STEP(o0, 4, pw2); PV_STEP(o1, 5, pw2); PV_STEP(o0, 6, pw3); PV_STEP(o1, 7, pw3);
#undef PV_STEP
        }
    }
}

__device__ __forceinline__ void moba_part(LAS unsigned char* lds, int wg, const bf16_t* Qp, const bf16_t* Kp, const bf16_t* Vp, int pitch, bf16_t* Op, int opitch,
                                          const float* KMEAN, bf16_t* PART, f32x2* ML) {
    const int tid = fresh_tid(), lane = tid & 63, r32 = lane & 31, hi = lane >> 5; const int wid = __builtin_amdgcn_readfirstlane(tid >> 6);
    const int bh = wg >> 1, part = wg & 1, b = bh >> 4, h = bh & 15;
    const int qb_lo = part ? 9 : 0, qb_hi = part ? 16 : 9, nq = (qb_hi - qb_lo) * 256;
    const size_t rowbase = (size_t)b * SEQ; const size_t pbase = (size_t)wg * MB_CAPR;
    LAS float* km = (LAS float*)(lds + MB_KM);
    LAS int* cnt = (LAS int*)(lds + MB_CNT); LAS int* off = cnt + 16;
    LAS unsigned short* LIST = (LAS unsigned short*)(lds + MB_LIST);
    LAS unsigned* PK = (LAS unsigned*)(lds + MB_PK);
    LAS float* wsf = (LAS float*)(lds + MB_WS) + wid * 256;
    bf16_t* POWN = (bf16_t*)(ML + (size_t)4 * 1024 * 1024) + (size_t)wg * 2304 * 64;
    f32x2* MLO = ML + (size_t)256 * MB_CAPR + (size_t)wg * 2304;
    for (int i = tid; i < 16 * 64; i += 512) km[i] = KMEAN[((size_t)b * 16 + (i >> 6)) * 1024 + h * 64 + (i & 63)];
    if (tid < 16) cnt[tid] = 0;
    __syncthreads();
#pragma unroll 1
    for (int qb = qb_lo; qb < qb_hi; ++qb) {
        const bf16_t* Qw = Qp + (rowbase + qb * 256 + wid * 32 + r32) * pitch + h * 64;
        bf16x8 qr[4];
#pragma unroll
        for (int d0 = 0; d0 < 4; ++d0) qr[d0] = *(const bf16x8*)(Qw + d0 * 16 + hi * 8);
        float qf[32];
#pragma unroll
        for (int d0 = 0; d0 < 4; ++d0)
#pragma unroll
            for (int j = 0; j < 8; ++j) qf[d0 * 8 + j] = __uint_as_float((unsigned)(unsigned short)qr[d0][j] << 16);
        float v1 = -INFINITY, v2 = -INFINITY, v3 = -INFINITY; int i1 = 0, i2 = 1, i3 = 2;
        if (qb > 3) {
            for (int n = 0; n < qb; ++n) {
                float part_ = 0.f;
#pragma unroll
                for (int d0 = 0; d0 < 4; ++d0) { const f32x4 ka = *(const LAS f32x4*)(km + n * 64 + d0 * 16 + hi * 8), kb = *(const LAS f32x4*)(km + n * 64 + d0 * 16 + hi * 8 + 4);
                    part_ += (qf[d0 * 8 + 0] * ka.x + qf[d0 * 8 + 1] * ka.y) + (qf[d0 * 8 + 2] * ka.z + qf[d0 * 8 + 3] * ka.w) + (qf[d0 * 8 + 4] * kb.x + qf[d0 * 8 + 5] * kb.y) + (qf[d0 * 8 + 6] * kb.z + qf[d0 * 8 + 7] * kb.w); }
                const float g = half_sum(part_);
                if (g > v1) { v3 = v2; i3 = i2; v2 = v1; i2 = i1; v1 = g; i1 = n; } else if (g > v2) { v3 = v2; i3 = i2; v2 = g; i2 = n; } else if (g > v3) { v3 = g; i3 = n; }
            }
        }
        const int npick = qb < 3 ? qb : 3;
        if (hi == 0) { const int tl = (qb - qb_lo) * 256 + wid * 32 + r32;
            unsigned e0 = 0xffffffffu, e1 = 0xffffffffu, e2 = 0xffffffffu;
            if (npick > 0) e0 = ((unsigned)i1 << 16) | (unsigned)__hip_atomic_fetch_add(cnt + i1, 1, __ATOMIC_RELAXED, __HIP_MEMORY_SCOPE_WORKGROUP);
            if (npick > 1) e1 = ((unsigned)i2 << 16) | (unsigned)__hip_atomic_fetch_add(cnt + i2, 1, __ATOMIC_RELAXED, __HIP_MEMORY_SCOPE_WORKGROUP);
            if (npick > 2) e2 = ((unsigned)i3 << 16) | (unsigned)__hip_atomic_fetch_add(cnt + i3, 1, __ATOMIC_RELAXED, __HIP_MEMORY_SCOPE_WORKGROUP);
            PK[tl * 3 + 0] = e0; PK[tl * 3 + 1] = e1; PK[tl * 3 + 2] = e2; }
    }
    __syncthreads();
    if (tid == 0) { int run = 0; for (int n = 0; n < 16; ++n) { off[n] = run; run += (cnt[n] + 31) & ~31; } off[16] = run; }
    __syncthreads();
    for (int tl = tid; tl < nq; tl += 512) {
#pragma unroll
        for (int s = 0; s < 3; ++s) { const unsigned e = PK[tl * 3 + s];
            if (e != 0xffffffffu) { const int row = off[e >> 16] + (int)(e & 0xffffu); LIST[row] = (unsigned short)(qb_lo * 256 + tl); PK[tl * 3 + s] = (unsigned)row; } }
    }
    if (tid < 16) { for (int r = off[tid] + cnt[tid]; r < off[tid + 1]; ++r) LIST[r] = (unsigned short)(qb_lo * 256); }
    __syncthreads();
#define MB_STORE_PARTIAL(DST, MLP) do { const float ltot_ = half_sum(lsum); \
        if (hi == 0) { wsf[r32] = 1.0f / ltot_; (MLP)[r32] = (f32x2){mhat, ltot_}; } \
        _Pragma("unroll") for (int g = 0; g < 4; ++g) { const f32x4 a4 = *(const LAS f32x4*)(wsf + 8 * g + 4 * hi); \
            _Pragma("unroll") for (int j = 0; j < 4; ++j) { const int r = 4 * g + j; const float inv_ = (j == 0) ? a4.x : (j == 1) ? a4.y : (j == 2) ? a4.z : a4.w; \
                ((unsigned*)(DST))[(size_t)crow(r, hi) * 32 + r32] = cvt_pk_bf16(o0[r] * inv_, o1[r] * inv_); } } } while (0)
    {
        u32x4 kr[4], vr[4];
#define MB_WORK(n_) ((off[(n_) + 1] > off[(n_)]) || ((n_) >= qb_lo && (n_) < qb_hi))
        int n = 0; while (n < 16 && !MB_WORK(n)) ++n;
        n = __builtin_amdgcn_readfirstlane(n);
        if (n < 16) moba_issue_block(kr, vr, lane, wid, Kp + (rowbase + n * 256) * pitch + h * 64, Vp + (rowbase + n * 256) * pitch + h * 64, pitch);
#pragma unroll 1
        while (n < 16) {
            const int o_n = __builtin_amdgcn_readfirstlane(off[n]), len = __builtin_amdgcn_readfirstlane(off[n + 1]) - o_n;
            const int G = len >> 5, T = G + ((n >= qb_lo && n < qb_hi) ? 8 : 0);
#define MB_TASK_ROW(j_) (((j_) < G) ? (int)LIST[o_n + 32 * (j_) + r32] : (n * 256 + (7 - ((j_) - G)) * 32 + r32))
            bf16x8 qr[4];
            if (wid < T) { const int t = MB_TASK_ROW(wid); const bf16_t* Qw = Qp + (rowbase + t) * pitch + h * 64;
#pragma unroll
                for (int d0 = 0; d0 < 4; ++d0) qr[d0] = *(const bf16x8*)(Qw + d0 * 16 + hi * 8); }
            __syncthreads();
            moba_commit_block(lds, kr, vr, lane, wid);
            __syncthreads();
            int nn = n + 1; while (nn < 16 && !MB_WORK(nn)) ++nn;
            nn = __builtin_amdgcn_readfirstlane(nn);
            if (nn < 16) moba_issue_block(kr, vr, lane, wid, Kp + (rowbase + nn * 256) * pitch + h * 64, Vp + (rowbase + nn * 256) * pitch + h * 64, pitch);
#pragma unroll 1
            for (int j = wid; j < T; j += 8) {
                bf16x8 qn[4];
                if (j + 8 < T) { const int t = MB_TASK_ROW(j + 8); const bf16_t* Qw = Qp + (rowbase + t) * pitch + h * 64;
#pragma unroll
                    for (int d0 = 0; d0 < 4; ++d0) qn[d0] = *(const bf16x8*)(Qw + d0 * 16 + hi * 8); }
                float mhat = 0.f, lsum = 0.f; f32x16 o0 = {}, o1 = {};
                if (j < G) {
                    moba_block<false>(lds, lane, wid, r32, hi, qr, 0, 0, mhat, lsum, o0, o1);
                    bf16_t* pdst = PART + (pbase + o_n + 32 * j) * 64; f32x2* mdst = ML + pbase + o_n + 32 * j;
                    MB_STORE_PARTIAL(pdst, mdst);
                } else { const int og = 7 - (j - G);
                    moba_block<true>(lds, lane, wid, r32, hi, qr, og * 32 + r32, og * 32 + 31, mhat, lsum, o0, o1);
                    bf16_t* pdst = POWN + ((size_t)(n - qb_lo) * 256 + og * 32) * 64; f32x2* mdst = MLO + (n - qb_lo) * 256 + og * 32;
                    MB_STORE_PARTIAL(pdst, mdst);
                }
                if (j + 8 < T) {
#pragma unroll
                    for (int d0 = 0; d0 < 4; ++d0) qr[d0] = qn[d0]; }
            }
            n = nn;
        }
#undef MB_TASK_ROW
#undef MB_WORK
    }
#undef MB_STORE_PARTIAL
    __syncthreads();
#pragma unroll 4
    for (int i = tid; i < nq * 8; i += 512) {
        const int tl = i >> 3, c = i & 7;
        const unsigned r1 = PK[tl * 3 + 0], r2 = PK[tl * 3 + 1], r3 = PK[tl * 3 + 2];
        const f32x2 so = MLO[tl];
        f32x2 s1 = {-1e30f, 0.f}, s2 = {-1e30f, 0.f}, s3 = {-1e30f, 0.f};
        if (r1 != 0xffffffffu) s1 = ML[pbase + r1]; if (r2 != 0xffffffffu) s2 = ML[pbase + r2]; if (r3 != 0xffffffffu) s3 = ML[pbase + r3];
        const float M = fmaxf(fmaxf(so.x, s1.x), fmaxf(s2.x, s3.x));
        const float wo = __builtin_amdgcn_exp2f(so.x - M) * so.y, w1 = __builtin_amdgcn_exp2f(s1.x - M) * s1.y, w2 = __builtin_amdgcn_exp2f(s2.x - M) * s2.y, w3 = __builtin_amdgcn_exp2f(s3.x - M) * s3.y;
        const float inv = 1.0f / (wo + w1 + w2 + w3);
        const u32x4 zero4 = {0u, 0u, 0u, 0u};
        const u32x4 xo = *(const u32x4*)(POWN + (size_t)tl * 64 + c * 8);
        const u32x4 x1 = (r1 != 0xffffffffu) ? *(const u32x4*)(PART + (pbase + r1) * 64 + c * 8) : zero4;
        const u32x4 x2 = (r2 != 0xffffffffu) ? *(const u32x4*)(PART + (pbase + r2) * 64 + c * 8) : zero4;
        const u32x4 x3 = (r3 != 0xffffffffu) ? *(const u32x4*)(PART + (pbase + r3) * 64 + c * 8) : zero4;
        const float fo = wo * inv, f1 = w1 * inv, f2 = w2 * inv, f3 = w3 * inv;
#define MB_LO(k) (fo * bf_lo(xo[k]) + (f1 * bf_lo(x1[k]) + f2 * bf_lo(x2[k]) + f3 * bf_lo(x3[k])))
#define MB_HI(k) (fo * bf_hi(xo[k]) + (f1 * bf_hi(x1[k]) + f2 * bf_hi(x2[k]) + f3 * bf_hi(x3[k])))
        bf16_t* orow = Op + (rowbase + qb_lo * 256 + tl) * opitch + h * 64 + c * 4;
        *(u32x2*)orow = (u32x2){cvt_pk_bf16(MB_LO(0), MB_LO(1)), cvt_pk_bf16(MB_LO(2), MB_LO(3))};
        *(u32x2*)(orow + 32) = (u32x2){cvt_pk_bf16(MB_HI(0), MB_HI(1)), cvt_pk_bf16(MB_HI(2), MB_HI(3))};
#undef MB_LO
#undef MB_HI
    }
    __syncthreads();
}

constexpr int FX_FB = 65536 + 8192;
__device__ __forceinline__ void fox_unit(LAS unsigned char* lds, const bf16_t* Qp, const bf16_t* Kp, const bf16_t* Vp, int pitch, bf16_t* Op, int opitch, int b, int h, int qb, const float* FLbh) {
    const int tid = fresh_tid(), lane = tid & 63, r32 = lane & 31, hi = lane >> 5; const int wid = __builtin_amdgcn_readfirstlane(tid >> 6);
    const size_t rowbase = (size_t)b * SEQ; const int q0 = qb * 256;
    const bf16_t* Qw = Qp + (rowbase + q0 + wid * 32 + r32) * pitch + h * 64;
    bf16x8 qr[4];
#pragma unroll
    for (int d0 = 0; d0 < 4; ++d0) qr[d0] = *(const bf16x8*)(Qw + d0 * 16 + hi * 8);
    const int NT = 4 * (qb + 1);
    const float flq0 = FLbh[q0], flw0 = FLbh[q0 + wid * 32];
    int t0u, t0w;
    { const bool live = lane < NT - 4; const float fe = live ? FLbh[64 * lane + 63] : 0.f;
      t0u = __builtin_popcountll(__ballot(live && (flq0 - fe < -AT_PRUNE))); t0w = __builtin_popcountll(__ballot(live && (flw0 - fe < -AT_PRUNE))); }
    t0u = __builtin_amdgcn_readfirstlane(t0u); t0w = __builtin_amdgcn_readfirstlane(t0w);
    const int kb0 = t0u >> 2;
    float mhat = -1e30f, lsum = 0.f; f32x16 o0 = {}, o1 = {};
    LAS float* wsf = (LAS float*)(lds + MB_WS) + wid * 256;
    LAS float* fbl = (LAS float*)(lds + FX_FB);
    const int kfo = hi * 1024 + r32 * 16;
    const int vfo = ((lane >> 4) & 1) * 32 + (lane & 3) * 8 + (4 * hi + ((lane & 15) >> 2)) * 64;
    const int qrel = wid * 32 + r32;
    const bf16_t* Kh = Kp + rowbase * pitch + h * 64; const bf16_t* Vh = Vp + rowbase * pitch + h * 64;
    u32x4 kr[4], vr[4]; float fr_ = 0.f;
    moba_issue_block(kr, vr, lane, wid, Kh + (size_t)kb0 * 256 * pitch, Vh + (size_t)kb0 * 256 * pitch, pitch);
    if (tid < 256) fr_ = flq0 - FLbh[kb0 * 256 + tid];
#pragma unroll 1
    for (int kb = kb0; kb <= qb; ++kb) {
        __syncthreads();
        moba_commit_block(lds, kr, vr, lane, wid);
        if (tid < 256) fbl[tid] = fr_;
        __syncthreads();
        if (kb < qb) { moba_issue_block(kr, vr, lane, wid, Kh + (size_t)(kb + 1) * 256 * pitch, Vh + (size_t)(kb + 1) * 256 * pitch, pitch); if (tid < 256) fr_ = flq0 - FLbh[(kb + 1) * 256 + tid]; }
        const bool diag = (kb == qb);
#pragma unroll 1
        for (int t = 0; t < 4; ++t) {
            if (kb * 4 + t < t0w) continue;
            if (diag && 64 * t > wid * 32 + 31) break;
            const LAS unsigned char* kb_ = lds + MB_KB + t * 8192 + kfo;
            f32x16 p0 = {}, p1 = {};
            bf16x8 kf[8];
#pragma unroll
            for (int d0 = 0; d0 < 4; ++d0) { kf[2 * d0] = *(const LAS bf16x8*)(kb_ + d0 * 2048); kf[2 * d0 + 1] = *(const LAS bf16x8*)(kb_ + d0 * 2048 + 512); }
            __builtin_amdgcn_sched_barrier(0);
#pragma unroll
            for (int d0 = 0; d0 < 4; ++d0) { p0 = __builtin_amdgcn_mfma_f32_32x32x16_bf16(kf[2 * d0], qr[d0], p0, 0, 0, 0); p1 = __builtin_amdgcn_mfma_f32_32x32x16_bf16(kf[2 * d0 + 1], qr[d0], p1, 0, 0, 0); }
            s16x4 vlo[8], vhi[8];
            { const LAS unsigned char* vq_ = lds + MB_VB + t * 8192 + vfo;
#pragma unroll
              for (int i = 0; i < 8; ++i) { vlo[i] = vtr(vq_ + (i & 1) * 4096 + (i >> 1) * 1024); vhi[i] = vtr(vq_ + (i & 1) * 4096 + (i >> 1) * 1024 + 512); } }
            __builtin_amdgcn_sched_barrier(0);
            { const LAS float* fb = fbl + 64 * t;
#pragma unroll
              for (int g = 0; g < 4; ++g) { const f32x4 fa = *(const LAS f32x4*)(fb + 8 * g + 4 * hi), fc = *(const LAS f32x4*)(fb + 32 + 8 * g + 4 * hi);
                  p0[4 * g + 0] += fa.x; p0[4 * g + 1] += fa.y; p0[4 * g + 2] += fa.z; p0[4 * g + 3] += fa.w; p1[4 * g + 0] += fc.x; p1[4 * g + 1] += fc.y; p1[4 * g + 2] += fc.z; p1[4 * g + 3] += fc.w; } }
            if (diag) { const int kbase = 64 * t + 4 * hi;
#pragma unroll
                for (int r = 0; r < 16; ++r) { const int kv = kbase + (r & 3) + 8 * (r >> 2); if (kv > qrel) p0[r] = -INFINITY; if (kv + 32 > qrel) p1[r] = -INFINITY; } }
            float rm = fmaxf(p0[0], p1[0]);
#pragma unroll
            for (int r = 1; r < 16; ++r) rm = fmaxf(rm, fmaxf(p0[r], p1[r]));
            rm = half_max(rm);
            if (__any(rm > mhat + AT_THR)) {
                const float mnew = fmaxf(mhat, rm), al = __builtin_amdgcn_exp2f(mhat - mnew); mhat = mnew; lsum *= al;
                if (hi == 0) wsf[r32] = al;
#pragma unroll
                for (int g = 0; g < 4; ++g) { const f32x4 a4 = *(const LAS f32x4*)(wsf + 8 * g + 4 * hi);
                    o0[4 * g + 0] *= a4.x; o0[4 * g + 1] *= a4.y; o0[4 * g + 2] *= a4.z; o0[4 * g + 3] *= a4.w; o1[4 * g + 0] *= a4.x; o1[4 * g + 1] *= a4.y; o1[4 * g + 2] *= a4.z; o1[4 * g + 3] *= a4.w; }
            }
            float ps = 0.f;
#pragma unroll
            for (int r = 0; r < 16; ++r) { p0[r] = __builtin_amdgcn_exp2f(p0[r] - mhat); p1[r] = __builtin_amdgcn_exp2f(p1[r] - mhat); ps += p0[r] + p1[r]; }
            lsum += ps;
            u32x4 pw0, pw1, pw2, pw3;
            pw0.x = cvt_pk_bf16(p0[0], p0[1]); pw0.y = cvt_pk_bf16(p0[2], p0[3]); pw0.z = cvt_pk_bf16(p0[4], p0[5]); pw0.w = cvt_pk_bf16(p0[6], p0[7]);
            pw1.x = cvt_pk_bf16(p0[8], p0[9]); pw1.y = cvt_pk_bf16(p0[10], p0[11]); pw1.z = cvt_pk_bf16(p0[12], p0[13]); pw1.w = cvt_pk_bf16(p0[14], p0[15]);
            pw2.x = cvt_pk_bf16(p1[0], p1[1]); pw2.y = cvt_pk_bf16(p1[2], p1[3]); pw2.z = cvt_pk_bf16(p1[4], p1[5]); pw2.w = cvt_pk_bf16(p1[6], p1[7]);
            pw3.x = cvt_pk_bf16(p1[8], p1[9]); pw3.y = cvt_pk_bf16(p1[10], p1[11]); pw3.z = cvt_pk_bf16(p1[12], p1[13]); pw3.w = cvt_pk_bf16(p1[14], p1[15]);
            __builtin_amdgcn_sched_barrier(0);
#define PV_STEP(OACC, I, PW) do { const bf16x8 vf_ = {vlo[I][0], vlo[I][1], vlo[I][2], vlo[I][3], vhi[I][0], vhi[I][1], vhi[I][2], vhi[I][3]}; \
                OACC = __builtin_amdgcn_mfma_f32_32x32x16_bf16(__builtin_bit_cast(bf16x8, PW), vf_, OACC, 0, 0, 0); } while (0)
            PV_STEP(o0, 0, pw0); PV_STEP(o1, 1, pw0); PV_STEP(o0, 2, pw1); PV_STEP(o1, 3, pw1);
            PV_STEP(o0, 4, pw2); PV_STEP(o1, 5, pw2); PV_STEP(o0, 6, pw3); PV_STEP(o1, 7, pw3);
#undef PV_STEP
        }
    }
    const float ltot = half_sum(lsum);
    if (hi == 0) wsf[r32] = 1.0f / ltot;
    bf16_t* Ow = Op + (rowbase + q0 + wid * 32) * opitch + h * 64 + r32;
#pragma unroll
    for (int g = 0; g < 4; ++g) { const f32x4 a4 = *(const LAS f32x4*)(wsf + 8 * g + 4 * hi);
#pragma unroll
        for (int j = 0; j < 4; ++j) { const int r = 4 * g + j; const float inv = (j == 0) ? a4.x : (j == 1) ? a4.y : (j == 2) ? a4.z : a4.w;
            bf16_t* orow = Ow + (size_t)crow(r, hi) * opitch;
            orow[0] = (bf16_t)(cvt_pk_bf16(o0[r] * inv, 0.f) & 0xffffu); orow[32] = (bf16_t)(cvt_pk_bf16(o1[r] * inv, 0.f) & 0xffffu); } }
    __syncthreads();
}

#ifndef E4F8_PAIR
#define E4F8_PAIR 1
#endif

struct Args { const float* in[19]; float* out; unsigned char* ws; };


typedef __attribute__((address_space(4))) const unsigned long long kq_t;
__device__ __forceinline__ kq_t* kargs() { kq_t* p = (kq_t*)__builtin_amdgcn_kernarg_segment_ptr(); asm volatile("" : "+s"(p)); return p; }
#define INP(k) ((const float*)(GAS const float*)kargs()[(k)])
#define OUTP ((float*)(GAS float*)kargs()[19])
#define WSP ((unsigned char*)(GAS unsigned char*)kargs()[20])
__device__ __forceinline__ void convert_even(int i, unsigned char* W, LAS unsigned char* lds, int vcu, int G) {
    const int tid = fresh_tid(), lane = tid & 63, wave = __builtin_amdgcn_readfirstlane(tid >> 6); LAS float* scr = (LAS float*)(lds + wave * 16384); const int gw = vcu * 8 + wave, NGW = G * 8;
    int base = 0;
    const float* w_in = INP(5) + (size_t)i * DM * EVEN_IN;
    conv_job(w_in, 0, DM, EVEN_IN, 0, 1536, (bf16_t*)(W + WE_IN), 0, 0, 0, nullptr, 0, 1, scr, gw, NGW, lane, base);
    conv_job(w_in, 0, DM, EVEN_IN, 1544, 512, (bf16_t*)(W + WE_IN), 0, 0, 1536, nullptr, 0, 1, scr, gw, NGW, lane, base);
    conv_job(INP(9) + (size_t)i * DM * DM, 0, DM, DM, 0, DM, (bf16_t*)(W + WE_OUT), 0, 0, 0, nullptr, 0, 1, scr, gw, NGW, lane, base);
    if (i == E4F8_PAIR) {
    conv_job8(INP(10) + (size_t)i * DM * FF, 0, DM, FF, FF, W + WE_GU, 0, 1, 0, S8_WGU, 1, (LAS unsigned char*)scr, gw, NGW, lane, base);
    conv_job8(INP(11) + (size_t)i * DM * FF, 0, DM, FF, FF, W + WE_GU, 0, 1, 128, S8_WGU, 1, (LAS unsigned char*)scr, gw, NGW, lane, base);
    } else {
    conv_job(INP(10) + (size_t)i * DM * FF, 0, DM, FF, 0, FF, (bf16_t*)(W + WE_GU), 0, 1, 0, nullptr, 0, 1, scr, gw, NGW, lane, base);
    conv_job(INP(11) + (size_t)i * DM * FF, 0, DM, FF, 0, FF, (bf16_t*)(W + WE_GU), 0, 1, 128, nullptr, 0, 1, scr, gw, NGW, lane, base);
    }
    conv_job8(INP(12) + (size_t)i * FF * DM, 0, FF, DM, DM, W + WE_DN, 0, 0, 0, S8_WDN, 1, (LAS unsigned char*)scr, gw, NGW, lane, base);
    conv_job(INP(7) + (size_t)i * 4 * 128 * 128, 128 * 128, 128, 128, 0, 128, (bf16_t*)(W + WE_POOL), 128 * 128, 0, 0, INP(8) + (size_t)i * 512, 128, 4, scr, gw, NGW, lane, base);
}
__device__ __forceinline__ void convert_odd(int i, unsigned char* W, LAS unsigned char* lds, int vcu, int G) {
    const int tid = fresh_tid(), lane = tid & 63, wave = __builtin_amdgcn_readfirstlane(tid >> 6); LAS float* scr = (LAS float*)(lds + wave * 16384); const int gw = vcu * 8 + wave, NGW = G * 8;
    int base = 0;
    conv_job8(INP(13) + (size_t)i * DM * 3 * DM, 0, DM, 3 * DM, 3 * DM, W + WO_IN, 0, 0, 0, S8_WGU, 1, (LAS unsigned char*)scr, gw, NGW, lane, base);
    conv_job(INP(14) + (size_t)i * DM * DM, 0, DM, DM, 0, DM, (bf16_t*)(W + WO_OUT), 0, 0, 0, nullptr, 0, 1, scr, gw, NGW, lane, base);
    conv_job8(INP(16) + (size_t)i * NEXP * DM * FF, (size_t)DM * FF, DM, FF, FF, W + WO_GU, (size_t)2 * FF * DM, 1, 0, S8_WGU, NEXP, (LAS unsigned char*)scr, gw, NGW, lane, base);
    conv_job8(INP(17) + (size_t)i * NEXP * DM * FF, (size_t)DM * FF, DM, FF, FF, W + WO_GU, (size_t)2 * FF * DM, 1, 128, S8_WGU, NEXP, (LAS unsigned char*)scr, gw, NGW, lane, base);
    conv_job8(INP(18) + (size_t)i * NEXP * FF * DM, (size_t)FF * DM, FF, DM, DM, W + WO_DN, (size_t)DM * FF, 0, 0, S8_WDN, NEXP, (LAS unsigned char*)scr, gw, NGW, lane, base);
}


#define NCV 384
#ifndef PMASK
#define PMASK 0xffffffffu
#endif
#define PH(k) if ((PMASK >> (k)) & 1u)
__global__ void __launch_bounds__(512, 2) trunk_fwd(Args a) {
    extern __shared__ __attribute__((aligned(16))) unsigned char lds_raw[];
    LAS unsigned char* lds = (LAS unsigned char*)lds_raw;
    volatile LAS unsigned* MISC = (volatile LAS unsigned*)(lds + MISC_OFF);
    const int tid = threadIdx.x;
    const int G0 = gridDim.x, bx0 = blockIdx.x;
    const int vcu0 = (bx0 % 8) * (G0 / 8) + bx0 / 8;
    for (int u = tid; u < (LDS_BYTES - MISC_OFF) / 4; u += 512) ((LAS unsigned*)(lds + MISC_OFF))[u] = 0u;
    __syncthreads();
    (void)xcd_barrier_post((unsigned*)(WSP + WS_CTL) + CW_BAR, MISC + 8);
#define GRID_BAR() do { XcdBarrier bar_; bar_.bar = (unsigned*)(WSP + WS_CTL) + CW_BAR; bar_.x = xb_xcc_id(); bar_.st = (volatile LAS unsigned*)(lds + MISC_OFF) + 8; xcd_barrier(bar_); } while (0)
#define G ls(G0)
#define bx ls(bx0)
#define vcu ls(vcu0)
#define XF OUTP
#define XB ((bf16_t*)(WSP + WS_XB))
#define WGT(off) ((const bf16_t*)(WSP + WS_W + (off)))
#define HC ((bf16_t*)(WSP + WS_BIG + BG_HC))
#define CAT ((bf16_t*)(WSP + WS_BIG + BG_CAT))
#define HID ((bf16_t*)(WSP + WS_BIG + BG_HID))
#define XS ((bf16_t*)(WSP + WS_XS))
#define XS8 (WSP + WS_BIG + BG_XS8)
#define YPRE ((bf16_t*)(WSP + WS_BIG + 256 * MiB))
#define HID8 (WSP + WS_BIG + BG_HID)
#define LOGF ((float*)(WSP + WS_LOGF))
#define FL ((float*)(WSP + WS_FL))
#define KMEAN ((float*)(WSP + WS_KMEAN))
#define RE ((unsigned*)(WSP + WS_RE))
#define RG ((f32x2*)(WSP + WS_RG))
#define RR ((unsigned*)(WSP + WS_RR))
#define POS ((i32x2*)(WSP + WS_POS))
#define CNT ((int*)(WSP + WS_CNT))
#define PB ((int*)(WSP + WS_PB))
#define QKV HC
#define OB CAT

    PH(0) convert_even(0, WSP + WS_W, lds, vcu, G);
    __syncthreads();
    PH(1) row_phase<RP_FORGET>(lds, vcu, INP(0), XF, XB, nullptr, nullptr, INP(5) + 1536, EVEN_IN, INP(6), LOGF, nullptr, nullptr, nullptr, nullptr, nullptr, nullptr, nullptr);
    GRID_BAR();

    for (int pair = 0; pair < 2; ++pair) {
        const int le = 2 * pair, lo = 2 * pair + 1;

        PH(2) if (vcu < 64) fox_scan(lds, vcu, LOGF, FL);
        PH(3) { pg8::Gemm g{XB, WGT(WE_IN), MTOK, 2048, DM}; pg8::StaticOrderT<8> S; S.init(MTOK, 2048, G, bx);
          pg8::EpiBf16 E{HC, 2048, 2, C2};
          pg8::gemm_phase<pg8::EpiBf16, pg8::StaticOrderT<8>, true, true>(lds, g, S, E); }
        GRID_BAR();


        PH(4) {
          gu32* qhead = (gu32*)(WSP + WS_CTL) + 64 + 64 * pair;
          volatile LAS unsigned* qslot = (volatile LAS unsigned*)(lds + MISC_OFF + 96);
#pragma unroll 1
          for (;;) {
              if (fresh_tid() == 0) qslot[0] = __hip_atomic_fetch_add(qhead, 1u, RLX_AGENT);
              __syncthreads();
              const int u = __builtin_amdgcn_readfirstlane((int)qslot[0]);
              __syncthreads();
              if (u >= 1024 + 512 + NCV) break;
              int v_;
              if (u < 4 * NCV) { if ((u & 3) == 3) { convert_odd(pair, WSP + WS_W, lds, u >> 2, NCV); continue; } v_ = u - (u >> 2); } else v_ = u - NCV;
              { const int u = v_;
              if (u < 1024) { const int h = 7 - (u >> 7), qb = 15 - ((u >> 3) & 15), b = u & 7;
                  fox_unit(lds, HC, HC + 512, HC + 1024, 2048, CAT, 1024, b, h, qb, FL + (size_t)(b * 8 + h) * SEQ); }
              else { const int v = u - 1024; pool_unit(lds, v >> 2, v & 3, HC, WGT(WE_POOL), CAT); } }
          } }
        GRID_BAR();


        PH(5) { pg8::Gemm g{CAT, WGT(WE_OUT), MTOK, DM, DM}; pg8::StaticOrderT<4> S; S.init(MTOK, DM, G, bx);
          pg8::EpiResid E{XB, YPRE, DM, ALPHA, 1.f};
          pg8::gemm_phase<pg8::EpiResid, pg8::StaticOrderT<4>, true, true>(lds, g, S, E); }
        GRID_BAR();
        PH(6) { if (pair == E4F8_PAIR) row_phase<RP_LN | RP_SRC_BF16 | RP_WRITE_X8>(lds, vcu, (const float*)YPRE, XF, XB, INP(1) + le * DM, INP(2) + le * DM, nullptr, 0, nullptr, nullptr, nullptr, nullptr, nullptr, nullptr, nullptr, nullptr, nullptr, XS8);
          else row_phase<RP_LN | RP_SRC_BF16>(lds, vcu, (const float*)YPRE, XF, XB, INP(1) + le * DM, INP(2) + le * DM, nullptr, 0, nullptr, nullptr, nullptr, nullptr, nullptr, nullptr, nullptr, nullptr, nullptr); }
        GRID_BAR();
        PH(7) { if (pair == E4F8_PAIR) { pg8::Gemm g{(const bf16_t*)XS8, WGT(WE_GU), MTOK, 2 * FF, DM / 2}; pg8::StaticOrderT<28> S; S.init(MTOK, 2 * FF, G, bx);
            pg8::EpiSwiGLU8 E{HID8, FF, 1.f / (S8_X * S8_WGU), S8_H};
            pg8::gemm_phase<pg8::EpiSwiGLU8, pg8::StaticOrderT<28>, true, true, true>(lds, g, S, E); }
          else { pg8::Gemm g{XB, WGT(WE_GU), MTOK, 2 * FF, DM}; pg8::StaticOrderT<28> S; S.init(MTOK, 2 * FF, G, bx);
            pg8::EpiSwiGLU8 E{HID8, FF, 1.f, S8_H};
            pg8::gemm_phase<pg8::EpiSwiGLU8, pg8::StaticOrderT<28>, true, true, false>(lds, g, S, E); } }
        GRID_BAR();
        PH(8) { pg8::Gemm g{(const bf16_t*)HID8, WGT(WE_DN), MTOK, DM, FF / 2}; pg8::StaticOrderT<4> S; S.init(MTOK, DM, G, bx);
          pg8::EpiResid E{XB, YPRE, DM, ALPHA, 1.f / (S8_H * S8_WDN)};
          pg8::gemm_phase<pg8::EpiResid, pg8::StaticOrderT<4>, true, true, true>(lds, g, S, E); }
        GRID_BAR();
        PH(9) row_phase<RP_LN | RP_SRC_BF16 | RP_WRITE_X8>(lds, vcu, (const float*)YPRE, XF, XB, INP(3) + le * DM, INP(4) + le * DM, nullptr, 0, nullptr, nullptr, nullptr, nullptr, nullptr, nullptr, nullptr, nullptr, nullptr, XS8);
        GRID_BAR();

        PH(11) { pg8::Gemm g{(const bf16_t*)XS8, WGT(WO_IN), MTOK, 3 * DM, DM / 2}; pg8::StaticOrderT<12> S; S.init(MTOK, 3 * DM, G, bx);
          pg8::EpiBf16 E{QKV, 3 * DM, 4, C2 / (S8_X * S8_WGU), 1.f / (S8_X * S8_WGU)};
          pg8::gemm_phase<pg8::EpiBf16, pg8::StaticOrderT<12>, true, true, true>(lds, g, S, E); }
        GRID_BAR();
        PH(12) kmean_unit(lds, vcu, QKV + DM, KMEAN);
        GRID_BAR();
        PH(13) moba_part(lds, vcu, QKV, QKV + DM, QKV + 2 * DM, 3 * DM, OB, DM, KMEAN, (bf16_t*)(WSP + WS_BIG + 256 * MiB), (f32x2*)(WSP + WS_XS));
        GRID_BAR();
        PH(14) { pg8::Gemm g{OB, WGT(WO_OUT), MTOK, DM, DM}; pg8::StaticOrderT<4> S; S.init(MTOK, DM, G, bx);
          pg8::EpiResid E{XB, YPRE, DM, ALPHA, 1.f};
          pg8::gemm_phase<pg8::EpiResid, pg8::StaticOrderT<4>, true, true>(lds, g, S, E); }
        GRID_BAR();
        PH(15) row_phase<RP_LN | RP_ROUTER | RP_SRC_BF16>(lds, vcu, (const float*)YPRE, XF, XB, INP(1) + lo * DM, INP(2) + lo * DM, INP(15) + (size_t)pair * DM * NEXP, NEXP, nullptr, nullptr, nullptr, nullptr, nullptr, RE, RG, RR, CNT);
        GRID_BAR();
        PH(16) moe_sort(lds, vcu, CNT, RE, RR, XB, XS8, POS, PB);
        GRID_BAR();
        { const int np = __builtin_amdgcn_readfirstlane(PB[8]);
          { LAS int* pl = (LAS int*)(lds + MISC_OFF + 2048); for (int i = fresh_tid(); i < np; i += 512) pl[i] = PB[16 + i]; __syncthreads(); }
          PH(17) { pg8::Gemm g{(const bf16_t*)XS8, WGT(WO_GU), np * 256, 2 * FF, DM / 2}; pg8::MoeOrderT<28> S; S.init(np, 2 * FF, G, bx, (LAS int*)(lds + MISC_OFF + 2048));
            pg8::EpiSwiGLU8 E{HID8, FF, 1.f / (S8_X * S8_WGU), S8_H};
            pg8::gemm_phase<pg8::EpiSwiGLU8, pg8::MoeOrderT<28>, true, true, true>(lds, g, S, E); }
          GRID_BAR();
          PH(18) { pg8::Gemm g{(const bf16_t*)HID8, WGT(WO_DN), np * 256, DM, FF / 2}; pg8::MoeOrderT<4> S; S.init(np, DM, G, bx, (LAS int*)(lds + MISC_OFF + 2048));
            pg8::EpiBf16 E{XS, DM, 1 << 30, 1.f / (S8_H * S8_WDN)};
            pg8::gemm_phase<pg8::EpiBf16, pg8::MoeOrderT<4>, true, true, true>(lds, g, S, E); }
          GRID_BAR(); }
        if (pair == 0) {
            PH(19) row_phase<RP_LN | RP_COMBINE | RP_FORGET | RP_SRC_BF16>(lds, vcu, (const float*)XB, XF, XB, INP(3) + lo * DM, INP(4) + lo * DM,
                INP(5) + (size_t)(pair + 1) * DM * EVEN_IN + 1536, EVEN_IN, INP(6) + (pair + 1) * 8, LOGF, XS, RG, POS, nullptr, nullptr, nullptr, nullptr);
            PH(20) convert_even(pair + 1, WSP + WS_W, lds, vcu, G);
            GRID_BAR();
        } else {
            PH(21) row_phase<RP_LN | RP_WRITE_XF | RP_COMBINE | RP_SRC_BF16>(lds, vcu, (const float*)XB, XF, XB, INP(3) + lo * DM, INP(4) + lo * DM,
                nullptr, 0, nullptr, nullptr, XS, RG, POS, nullptr, nullptr, nullptr, nullptr);
        }
    }
}

#undef G
#undef bx
#undef vcu
#undef XF
#undef XB
#undef HC
#undef CAT
#undef HID
#undef XS
#undef XS8
#undef YPRE
#undef HID8
#undef LOGF
#undef FL
#undef KMEAN
#undef RE
#undef RG
#undef RR
#undef POS
#undef CNT
#undef PB
#undef QKV
#undef OB
extern "C" void kernel_launch(void* const* d_in, const int* in_sizes, int n_in, void* d_out, int out_size, void* d_ws, size_t ws_size, hipStream_t stream) {
    static int grid = 0;
    if (grid == 0) {
        if (n_in != 19 || in_sizes[0] != MTOK * DM || out_size != MTOK * DM || ws_size < WS_END) { fprintf(stderr, "kernel_launch: unexpected shapes (n_in %d, out %d, ws %zu); nothing launched\n", n_in, out_size, ws_size); grid = -1; return; }
        int dev = 0, cus = 0, per_cu = 0;
        if (hipGetDevice(&dev) != hipSuccess || hipDeviceGetAttribute(&cus, hipDeviceAttributeMultiprocessorCount, dev) != hipSuccess) { grid = -1; return; }
        if (hipFuncSetAttribute((const void*)trunk_fwd, hipFuncAttributeMaxDynamicSharedMemorySize, LDS_BYTES) != hipSuccess) { fprintf(stderr, "kernel_launch: hipFuncSetAttribute failed\n"); grid = -1; return; }
        if (hipOccupancyMaxActiveBlocksPerMultiprocessor(&per_cu, (const void*)trunk_fwd, 512, LDS_BYTES) != hipSuccess || per_cu < 1) fprintf(stderr, "kernel_launch: occupancy query reports %d\n", per_cu);
        (void)hipGetLastError();
        grid = cus;
        if (grid != 256) { fprintf(stderr, "kernel_launch: built for 256 CUs, found %d; nothing launched\n", cus); grid = -1; return; }
    }
    if (grid < 0) return;
    if (hipMemsetAsync((char*)d_ws + WS_CTL, 0, CTL_ZERO_BYTES, stream) != hipSuccess) return;
    Args a{};
    for (int i = 0; i < 19; ++i) a.in[i] = (const float*)d_in[i];
    a.out = (float*)d_out; a.ws = (unsigned char*)d_ws;
    hipLaunchKernelGGL(trunk_fwd, dim3(grid), dim3(512), LDS_BYTES, stream, a);
}
```
